# Optimizing an MI355X kernel written in HIP

```python
import jax, jax.numpy as jnp
from jax import lax
import numpy as np

D_MODEL = 1024
BATCH = 16
SEQ = 2048
DEPTH = 1

MEM_LEN = 256
EPS = 1e-6

HG_HEADS = 4
HG_DK = 128
HG_DV = 128
HG_WIDTH = HG_HEADS * HG_DV
HG_KEY_WIDTH = HG_HEADS * HG_DK
HG_CHUNK = 64

SW_HEADS = 8
SW_KV_HEADS = 2
SW_GROUP = SW_HEADS // SW_KV_HEADS
SW_HEAD_DIM = 64
SW_WIDTH = SW_HEADS * SW_HEAD_DIM
WINDOW = 128
SW_BLOCK = 128
ROPE_THETA = 500000.0
ROT_DIM = SW_HEAD_DIM // 4

MIX_WIDTH = HG_WIDTH + SW_WIDTH
IN_SPLITS = (HG_KEY_WIDTH, HG_KEY_WIDTH, HG_WIDTH, HG_WIDTH,
             SW_WIDTH, SW_KV_HEADS * SW_HEAD_DIM, SW_KV_HEADS * SW_HEAD_DIM)
IN_WIDTH = sum(IN_SPLITS)

XA_HEADS = 4
XA_HEAD_DIM = 128
XA_WIDTH = XA_HEADS * XA_HEAD_DIM

D_FF = 4 * D_MODEL

kernel_name = "hymba_style_hgrn2_swa_sink_hybrid"


def rms_norm(x, g):
    xf = x.astype(jnp.float32)
    y = xf * lax.rsqrt(jnp.mean(xf * xf, axis=-1, keepdims=True) + EPS)
    return (y * g.astype(jnp.float32)).astype(x.dtype)


def head_rms(t, g):
    return t * lax.rsqrt(jnp.mean(t * t, axis=-1, keepdims=True) + EPS) * g.astype(jnp.float32)


def partial_rope(t, positions):
    half = ROT_DIM // 2
    inv_freq = ROPE_THETA ** (-(jnp.arange(half, dtype=jnp.float32) * 2.0 / ROT_DIM))
    ang = positions.astype(jnp.float32)[..., None] * inv_freq
    cos = jnp.cos(ang)[:, :, None, :]
    sin = jnp.sin(ang)[:, :, None, :]
    x1 = t[..., :half]
    x2 = t[..., half:ROT_DIM]
    return jnp.concatenate([x1 * cos - x2 * sin, x2 * cos + x1 * sin, t[..., ROT_DIM:]], axis=-1)


def hgrn2_group(q, f_logit, i, g, lb, norm_g):
    B, S, _ = q.shape
    H, C = HG_HEADS, HG_CHUNK
    nc = S // C
    qf = q.astype(jnp.float32).reshape(B, S, H, HG_DK)
    vf = i.astype(jnp.float32).reshape(B, S, H, HG_DV)
    lbh = lb.astype(jnp.float32).reshape(H, HG_DK)
    f = lbh + (1.0 - lbh) * jax.nn.sigmoid(f_logit.astype(jnp.float32).reshape(B, S, H, HG_DK))
    kf = 1.0 - f
    log_f = jnp.log(f)

    def to_chunks(t):
        return t.reshape(B, nc, C, H, t.shape[-1]).transpose(1, 0, 3, 2, 4)

    causal = jnp.tril(jnp.ones((C, C), dtype=bool))[:, :, None]

    def step(state, inp):
        qc, kc, vc, lfc = inp
        b = jnp.cumsum(lfc, axis=2)
        o_inter = jnp.einsum('bhik,bhkv->bhiv', qc * jnp.exp(b), state)
        diff = b[:, :, :, None, :] - b[:, :, None, :, :]
        decay = jnp.exp(jnp.where(causal, diff, -jnp.inf))
        scores = jnp.einsum('bhik,bhjk,bhijk->bhij', qc, kc, decay)
        o_intra = jnp.einsum('bhij,bhjv->bhiv', scores, vc)
        b_last = b[:, :, -1:, :]
        new_state = (jnp.exp(b_last[:, :, 0, :])[..., None] * state
                     + jnp.einsum('bhjk,bhjv->bhkv', kc * jnp.exp(b_last - b), vc))
        return new_state, o_inter + o_intra

    s0 = jnp.zeros((B, H, HG_DK, HG_DV), jnp.float32)
    _, o = lax.scan(step, s0, (to_chunks(qf), to_chunks(kf), to_chunks(vf), to_chunks(log_f)))
    o = o.transpose(1, 0, 3, 2, 4).reshape(B, S, H, HG_DV)
    gate = jax.nn.silu(g.astype(jnp.float32)).reshape(B, S, H, HG_DV)
    return (head_rms(o, norm_g) * gate).reshape(B, S, HG_WIDTH)


def swa_group(q, k, v, positions, q_norm_g, k_norm_g, sinks):
    B, S, _ = q.shape
    nb = S // SW_BLOCK
    qf = partial_rope(head_rms(q.astype(jnp.float32).reshape(B, S, SW_HEADS, SW_HEAD_DIM), q_norm_g), positions)
    kf = partial_rope(head_rms(k.astype(jnp.float32).reshape(B, S, SW_KV_HEADS, SW_HEAD_DIM), k_norm_g), positions)
    vf = v.astype(jnp.float32).reshape(B, S, SW_KV_HEADS, SW_HEAD_DIM)

    qb = qf.reshape(B, nb, SW_BLOCK, SW_KV_HEADS, SW_GROUP, SW_HEAD_DIM)

    def band(t):
        tp = jnp.pad(t, ((0, 0), (SW_BLOCK, 0), (0, 0), (0, 0))).reshape(B, nb + 1, SW_BLOCK, SW_KV_HEADS, SW_HEAD_DIM)
        return jnp.concatenate([tp[:, :-1], tp[:, 1:]], axis=2)

    kw, vw = band(kf), band(vf)
    s = jnp.einsum('bnqhgd,bnkhd->bnhgqk', qb, kw) * (SW_HEAD_DIM ** -0.5)

    qi = jnp.arange(SW_BLOCK)[:, None]
    kj = jnp.arange(2 * SW_BLOCK)[None, :]
    dist = qi + SW_BLOCK - kj
    in_band = (dist >= 0) & (dist < WINDOW)
    blk = jnp.arange(nb)[:, None, None]
    valid = in_band[None] & (blk * SW_BLOCK + kj[None] - SW_BLOCK >= 0)
    s = jnp.where(valid[None, :, None, None], s, -jnp.inf)

    sink = sinks.astype(jnp.float32).reshape(SW_KV_HEADS, SW_GROUP)[None, None, :, :, None, None]
    m = jnp.maximum(jnp.max(s, axis=-1, keepdims=True), sink)
    p = jnp.exp(s - m)
    denom = jnp.sum(p, axis=-1, keepdims=True) + jnp.exp(sink - m)
    o = jnp.einsum('bnhgqk,bnkhd->bnqhgd', p / denom, vw)
    return o.reshape(B, S, SW_WIDTH)


def memory_cross_attention(hn, mn, wq, wkv, q_norm_g, k_norm_g, wo):
    B, S, _ = hn.shape
    M = mn.shape[1]
    q = head_rms((hn @ wq).astype(jnp.float32).reshape(B, S, XA_HEADS, XA_HEAD_DIM), q_norm_g)
    kv = (mn @ wkv).astype(jnp.float32)
    k = head_rms(kv[..., :XA_WIDTH].reshape(B, M, XA_HEADS, XA_HEAD_DIM), k_norm_g)
    v = kv[..., XA_WIDTH:].reshape(B, M, XA_HEADS, XA_HEAD_DIM)
    s = jnp.einsum('bshd,bmhd->bhsm', q, k) * (XA_HEAD_DIM ** -0.5)
    p = jax.nn.softmax(s, axis=-1)
    o = jnp.einsum('bhsm,bmhd->bshd', p, v).reshape(B, S, XA_WIDTH)
    return o.astype(hn.dtype) @ wo


def setup_inputs(seed: int = 0) -> dict:
    key = jax.random.key(seed)
    ks = jax.random.split(key, 24)
    f32 = jnp.float32

    def nrm(k, shape, scale):
        return jax.random.normal(k, shape, f32) * scale

    def gain(k, shape):
        return 1.0 + 0.02 * jax.random.normal(k, shape, f32)

    offs = jax.random.randint(ks[2], (BATCH, 1), 0, 4096, dtype=jnp.int32)
    positions = (offs + jnp.arange(SEQ, dtype=jnp.int32)[None, :]).astype(jnp.int32)
    return {
        "x": nrm(ks[0], (BATCH, SEQ, D_MODEL), 1.0),
        "mem": nrm(ks[1], (BATCH, MEM_LEN, D_MODEL), 1.0),
        "positions": positions,
        "norm1_g": gain(ks[3], (DEPTH, D_MODEL)),
        "w_in": nrm(ks[4], (DEPTH, D_MODEL, IN_WIDTH), D_MODEL ** -0.5),
        "hg_lower_bounds": nrm(ks[5], (DEPTH + 1, HG_KEY_WIDTH), 0.1),
        "hg_norm_g": gain(ks[6], (DEPTH, HG_DV)),
        "sw_q_norm_g": gain(ks[7], (DEPTH, SW_HEAD_DIM)),
        "sw_k_norm_g": gain(ks[8], (DEPTH, SW_HEAD_DIM)),
        "sw_sinks": nrm(ks[9], (DEPTH, SW_HEADS), 0.5),
        "w_out": nrm(ks[10], (DEPTH, MIX_WIDTH, D_MODEL), MIX_WIDTH ** -0.5),
        "norm2_g": gain(ks[11], (DEPTH, D_MODEL)),
        "mem_norm_g": gain(ks[12], (DEPTH, D_MODEL)),
        "xa_wq": nrm(ks[13], (DEPTH, D_MODEL, XA_WIDTH), D_MODEL ** -0.5),
        "xa_wkv": nrm(ks[14], (DEPTH, D_MODEL, 2 * XA_WIDTH), D_MODEL ** -0.5),
        "xa_q_norm_g": gain(ks[15], (DEPTH, XA_HEAD_DIM)),
        "xa_k_norm_g": gain(ks[16], (DEPTH, XA_HEAD_DIM)),
        "xa_wo": nrm(ks[17], (DEPTH, XA_WIDTH, D_MODEL), XA_WIDTH ** -0.5),
        "norm3_g": gain(ks[18], (DEPTH, D_MODEL)),
        "mlp_up": nrm(ks[19], (DEPTH, D_MODEL, D_FF), D_MODEL ** -0.5),
        "mlp_down": nrm(ks[20], (DEPTH, D_FF, D_MODEL), D_FF ** -0.5),
    }


def reference(x, mem, positions, norm1_g, w_in, hg_lower_bounds, hg_norm_g, sw_q_norm_g,
              sw_k_norm_g, sw_sinks, w_out, norm2_g, mem_norm_g, xa_wq, xa_wkv, xa_q_norm_g,
              xa_k_norm_g, xa_wo, norm3_g, mlp_up, mlp_down):
    lb_all = jnp.cumsum(jax.nn.softmax(hg_lower_bounds.astype(jnp.float32), axis=0), axis=0)
    split_points = [int(p) for p in np.cumsum(IN_SPLITS)[:-1]]
    h = x
    for l in range(DEPTH):
        hn = rms_norm(h, norm1_g[l])
        proj = hn @ w_in[l]
        hq, hf, hi, hg, sq, sk, sv = jnp.split(proj, split_points, axis=-1)
        y_hg = hgrn2_group(hq, hf, hi, hg, lb_all[l], hg_norm_g[l])
        y_sw = swa_group(sq, sk, sv, positions, sw_q_norm_g[l], sw_k_norm_g[l], sw_sinks[l])
        mix = jnp.concatenate([y_hg, y_sw], axis=-1).astype(h.dtype) @ w_out[l]
        h = h + mix
        hn = rms_norm(h, norm2_g[l])
        mn = rms_norm(mem, mem_norm_g[l])
        h = h + memory_cross_attention(hn, mn, xa_wq[l], xa_wkv[l], xa_q_norm_g[l], xa_k_norm_g[l], xa_wo[l])
        hn = rms_norm(h, norm3_g[l])
        a = jax.nn.relu(hn @ mlp_up[l])
        h = h + (a * a) @ mlp_down[l]
    return h
```

```cpp
#include <hip/hip_runtime.h>
#include <hip/hip_cooperative_groups.h>
#include <cstdio>
#include <cstdint>
namespace cg = cooperative_groups;

#ifndef DIS_MASK
#define DIS_MASK 0
#endif
#ifndef MK_N_LAUNCHES
#define MK_N_LAUNCHES 1
#endif

#define LAS __attribute__((address_space(3)))
#define GAS __attribute__((address_space(1)))
typedef unsigned short bf16_t;
typedef short bf16x8 __attribute__((ext_vector_type(8)));
typedef float f32x4 __attribute__((ext_vector_type(4)));
typedef unsigned u32x4 __attribute__((ext_vector_type(4)));
typedef unsigned u32x2 __attribute__((ext_vector_type(2)));

constexpr int D = 1024, BATCH = 16, SEQ = 2048, M = BATCH * SEQ, MEMLEN = 256, MM = BATCH * MEMLEN;
constexpr int INW = 2816, FF = 4096;
constexpr float EPS = 1e-6f;

constexpr size_t MiB = 1u << 20;
constexpr size_t WS_CTL = 0, CTL_ZERO_BYTES = 64 * 1024;
constexpr size_t WS_SS2 = 1 * MiB, WS_SS3 = 1 * MiB + 256 * 1024;
constexpr size_t WS_LB = 1 * MiB + 512 * 1024;
constexpr size_t WS_WIN = 2 * MiB;
constexpr size_t WS_WOUT = WS_WIN + (size_t)INW * D * 2;
constexpr size_t WS_WQ = WS_WOUT + (size_t)D * D * 2;
constexpr size_t WS_WKV = WS_WQ + (size_t)512 * D * 2;
constexpr size_t WS_WO = WS_WKV + (size_t)D * D * 2;
constexpr size_t WS_WUP = WS_WO + (size_t)D * 512 * 2;
constexpr size_t WS_WDN = WS_WUP + (size_t)FF * D * 2;
constexpr size_t WS_ROPE = 30 * MiB;
constexpr size_t WS_KVM = 32 * MiB;
constexpr size_t WS_ELAST = 40 * MiB;
constexpr size_t WS_KN = 42 * MiB;
constexpr size_t WS_HB = 48 * MiB;
constexpr size_t WS_QX = 112 * MiB;
constexpr size_t WS_XO = 144 * MiB;
constexpr size_t WS_MIX = 176 * MiB;
constexpr size_t WS_R = 240 * MiB;
constexpr size_t WS_HN1 = WS_R;
constexpr size_t WS_MN = WS_R + 64 * MiB;
constexpr size_t WS_QT = WS_R + 72 * MiB;
constexpr size_t WS_KT = WS_R + 104 * MiB;
constexpr size_t WS_V = WS_R + 136 * MiB;
constexpr size_t WS_SG = WS_R + 168 * MiB;
constexpr size_t WS_SQ = WS_R + 200 * MiB;
constexpr size_t WS_SK = WS_R + 232 * MiB;
constexpr size_t WS_SV = WS_R + 240 * MiB;
constexpr size_t WS_ACT = WS_R;
constexpr size_t WS_END = WS_R + 256 * MiB;
static_assert(WS_WDN + (size_t)D * FF * 2 <= WS_ROPE, "weights fit");

constexpr int RING_BYTES = 131072, LDSCTL_OFF = 151552, LDS_BYTES = 155648;

__device__ __forceinline__ unsigned f2bf(float f) { unsigned u = __builtin_bit_cast(unsigned, f); return (u + 0x7fffu + ((u >> 16) & 1u)) >> 16; }
__device__ __forceinline__ unsigned pk2(float lo, float hi) { return f2bf(lo) | (f2bf(hi) << 16); }
__device__ __forceinline__ float bf2f(unsigned short b) { return __builtin_bit_cast(float, (unsigned)b << 16); }
__device__ __forceinline__ float bflo(unsigned w) { return __builtin_bit_cast(float, w << 16); }
__device__ __forceinline__ float bfhi(unsigned w) { return __builtin_bit_cast(float, w & 0xffff0000u); }
__device__ __forceinline__ unsigned cvt_pk_bf16(float lo, float hi) { unsigned r; asm volatile("v_cvt_pk_bf16_f32 %0, %1, %2" : "=v"(r) : "v"(lo), "v"(hi)); return r; }
__device__ __forceinline__ u32x4 pack8(const f32x4& a, const f32x4& b) { u32x4 w; w.x = cvt_pk_bf16(a[0], a[1]); w.y = cvt_pk_bf16(a[2], a[3]); w.z = cvt_pk_bf16(b[0], b[1]); w.w = cvt_pk_bf16(b[2], b[3]); return w; }
__device__ __forceinline__ float wave_sum(float v) {
#pragma unroll
    for (int o = 1; o < 64; o <<= 1) v += __shfl_xor(v, o);
    return v;
}
__device__ __forceinline__ float wave_max(float v) {
#pragma unroll
    for (int o = 1; o < 64; o <<= 1) v = fmaxf(v, __shfl_xor(v, o));
    return v;
}
__device__ __forceinline__ float fexp(float x) { return __builtin_amdgcn_exp2f(x * 1.4426950408889634f); }
__device__ __forceinline__ float frcp(float x) { return __builtin_amdgcn_rcpf(x); }
__device__ __forceinline__ float frsq(float x) { return __builtin_amdgcn_rsqf(x); }
__device__ __forceinline__ float flog(float x) { return __builtin_amdgcn_logf(x) * 0.6931471805599453f; }
template <int N> __device__ __forceinline__ float dpp_row_shr(float v) {
    return __builtin_bit_cast(float, __builtin_amdgcn_update_dpp(0, __builtin_bit_cast(int, v), 0x110 + N, 0xf, 0xf, false));
}
template <int N> __device__ __forceinline__ float dpp_row_shr1(float v) {
    return __builtin_bit_cast(float, __builtin_amdgcn_update_dpp(0x3f800000, __builtin_bit_cast(int, v), 0x110 + N, 0xf, 0xf, false));
}
__device__ __forceinline__ float row16_prefix_mul(float p) {
    p *= dpp_row_shr1<1>(p); p *= dpp_row_shr1<2>(p); p *= dpp_row_shr1<4>(p); p *= dpp_row_shr1<8>(p); return p;
}
__device__ __forceinline__ float row16_prefix(float p) {
    p += dpp_row_shr<1>(p); p += dpp_row_shr<2>(p); p += dpp_row_shr<4>(p); p += dpp_row_shr<8>(p); return p;
}

namespace pg8 {
constexpr int BM = 256, BK = 64, HALF = 128, HTB = HALF * BK * 2, NXCD = 8, WGM = 8;
__host__ __device__ __forceinline__ int lds_byte(int r, int c) { const int st = (r >> 4) * 2 + (c >> 5), rr = r & 15, cc = c & 31, ob = rr * 64 + cc * 2; return st * 1024 + (ob ^ (((ob >> 9) & 1) << 5)); }
__host__ __device__ __forceinline__ void stage_rc(int b, int& R, int& C) { const int st = b / 1024, sb = b % 1024, swz = sb ^ (((sb >> 9) & 1) << 5); R = (st >> 1) * 16 + swz / 64; C = (st & 1) * 32 + (swz % 64) / 2; }
__host__ __device__ __forceinline__ int perm32(int rho) { const int n = rho >> 4, i = rho & 15; return 8 * (i >> 2) + 4 * n + (i & 3); }

struct Unit { int pm, pn, kind; };
__device__ __forceinline__ void map_tile(int L, int nM, int nN, int& pm, int& pn) {
    const int nwg = nM * nN; int wgid = L;
    { const int q = nwg / NXCD, r = nwg % NXCD, xcd = wgid % NXCD, off = wgid / NXCD; wgid = (xcd < r ? xcd * (q + 1) : r * (q + 1) + (xcd - r) * q) + off; }
    const int nig = WGM * nN, gid = wgid / nig, fm = gid * WGM, gsz = (nM - fm) < WGM ? (nM - fm) : WGM;
    pm = fm + ((wgid % nig) % gsz); pn = (wgid % nig) / gsz;
}
struct Sched {
    const char *A0, *B0, *A1, *B1; int nM0, nN0, n0, n1, G, c; size_t tstep; int nrep; int pnoff = 0;
    __device__ __forceinline__ bool next(int i, Unit& u) const {
        int L = i * G + c;
        if (nrep > 1) { if (L < n0 * nrep) { const int pass = L / n0; map_tile(L - pass * n0, nM0, nN0, u.pm, u.pn); u.kind = (pass + 1 < nrep) ? 2 : 0; return true; } L -= n0 * (nrep - 1); }
        if (L < n0) { map_tile(L, nM0, nN0, u.pm, u.pn); u.pn += pnoff; u.kind = 0; return true; }
        if (L < n0 + n1) { const int idx = L - n0; u.pm = idx >> 2; u.pn = idx & 3; u.kind = 1; return true; }
        return false;
    }
    __device__ __forceinline__ const char* aptr(const Unit& u) const { return (u.kind == 1 ? A1 : A0) + (size_t)u.pm * tstep; }
    __device__ __forceinline__ const char* bptr(const Unit& u) const { return (u.kind == 1 ? B1 : B0) + (size_t)u.pn * tstep; }
};

template <class Epi, bool ALIGN_EPI, bool SP2>
__device__ __forceinline__ void gemm_phase(LAS unsigned char* lds, const int K, const Sched& S, const Epi& E) {
    const int tid = threadIdx.x, wid = __builtin_amdgcn_readfirstlane(tid >> 6), lane = tid & 63, wr = wid >> 2, wc = wid & 3, fr = lane & 15, fq = lane >> 4;
    const int nt = K / BK;
    unsigned voffA[2], voffB[2];
#pragma unroll
    for (int i = 0; i < 2; ++i) { int R, C; stage_rc(tid * 16 + i * 8192, R, C); const int Rb = (R & ~31) + perm32(R & 31);
        voffA[i] = (unsigned)(R * K + C) * 2u; voffB[i] = (unsigned)(Rb * K + C) * 2u; }
    const size_t kstep = (size_t)(BK * 2);
    const size_t hstep = (size_t)HALF * K * 2;
    const unsigned ldsw = (unsigned)wid * 1024u;
    const int aoff = lds_byte(wr * 64 + fr, fq * 8), boff = lds_byte(wc * 32 + fr, fq * 8);
#define PG8_SA(b, h) (((b) * 2 + (h)) * HTB)
#define PG8_SB(b, h) ((4 + (b) * 2 + (h)) * HTB)
#define PG8_STAGE(bufoff, gbase, voff) do { _Pragma("unroll") for (int _i = 0; _i < 2; ++_i) \
        __builtin_amdgcn_global_load_lds((const unsigned*)((const char*)(gbase) + (voff)[_i]), (LAS unsigned*)(lds + (bufoff) + ldsw + _i * 8192), 16, 0, 0); } while (0)
#define PG8_LDA(dst, b, h) do { _Pragma("unroll") for (int m = 0; m < 4; ++m) _Pragma("unroll") for (int k = 0; k < 2; ++k) dst[m][k] = *(const LAS bf16x8*)(lds + PG8_SA(b, h) + aoff + m * 2048 + k * 1024); } while (0)
#define PG8_LDB(dst, b, h) do { _Pragma("unroll") for (int n = 0; n < 2; ++n) _Pragma("unroll") for (int k = 0; k < 2; ++k) dst[n][k] = *(const LAS bf16x8*)(lds + PG8_SB(b, h) + boff + n * 2048 + k * 1024); } while (0)
#define PG8_MMA(ai, bj, At, Bt) do { __builtin_amdgcn_s_setprio(1); _Pragma("unroll") for (int m = 0; m < 4; ++m) _Pragma("unroll") for (int n = 0; n < 2; ++n) _Pragma("unroll") for (int k = 0; k < 2; ++k) \
        acc[ai][bj][m][n] = __builtin_amdgcn_mfma_f32_16x16x32_bf16(Bt[n][k], At[m][k], acc[ai][bj][m][n], 0, 0, 0); __builtin_amdgcn_s_setprio(0); } while (0)
#define PG8_WAIT_V(n) asm volatile("s_waitcnt vmcnt(" #n ")" ::: "memory")
#define PG8_WAIT_L(n) asm volatile("s_waitcnt lgkmcnt(" #n ")" ::: "memory")
#define PG8_BAR __builtin_amdgcn_s_barrier()
#define PG8_SCHED __builtin_amdgcn_sched_barrier(0)
    Unit cur, nxt; int ui = 0;
    if (!S.next(0, cur)) return;
    f32x4 acc[2][2][4][2];
#pragma unroll
    for (int a = 0; a < 2; ++a)
#pragma unroll
        for (int b = 0; b < 2; ++b)
#pragma unroll
            for (int m = 0; m < 4; ++m)
#pragma unroll
                for (int n = 0; n < 2; ++n) acc[a][b][m][n] = (f32x4){0.f, 0.f, 0.f, 0.f};
    bf16x8 At[4][2], B0[2][2], B1[2][2];
    const char* cA = S.aptr(cur); const char* cB = S.bptr(cur);
    if constexpr (SP2) {
        PG8_STAGE(PG8_SB(0, 0), cB, voffB); PG8_STAGE(PG8_SB(0, 1), cB + hstep, voffB); PG8_STAGE(PG8_SA(0, 0), cA, voffA); PG8_STAGE(PG8_SA(0, 1), cA + hstep, voffA);
        if (wr == 1) PG8_BAR;
        PG8_WAIT_V(2); PG8_BAR;
        PG8_STAGE(PG8_SB(1, 0), cB + kstep, voffB); PG8_STAGE(PG8_SA(1, 0), cA + kstep, voffA); PG8_STAGE(PG8_SB(1, 1), cB + hstep + kstep, voffB);
        PG8_WAIT_V(6); PG8_BAR;
    } else {
        PG8_STAGE(PG8_SB(0, 0), cB, voffB); PG8_STAGE(PG8_SA(0, 0), cA, voffA); PG8_STAGE(PG8_SB(0, 1), cB + hstep, voffB); PG8_STAGE(PG8_SA(0, 1), cA + hstep, voffA);
        if (wr == 1) PG8_BAR;
        PG8_WAIT_V(4); PG8_BAR;
        PG8_STAGE(PG8_SB(1, 0), cB + kstep, voffB); PG8_STAGE(PG8_SA(1, 0), cA + kstep, voffA); PG8_STAGE(PG8_SB(1, 1), cB + hstep + kstep, voffB);
        PG8_WAIT_V(6); PG8_BAR;
    }
    for (;;) {
        const bool has_next = S.next(ui + 1, nxt);
        const char* nA = has_next ? S.aptr(nxt) : cA; const char* nB = has_next ? S.bptr(nxt) : cB;
        for (int t = 0; t < nt; t += 2) {
            const bool last = (t == nt - 2);
            const char* a1 = cA + (size_t)(t + 1) * kstep;
            const char* a2 = last ? nA : cA + (size_t)(t + 2) * kstep; const char* b2 = last ? nB : cB + (size_t)(t + 2) * kstep;
            const char* a3 = a2 + kstep; const char* b3 = b2 + kstep;
            if constexpr (SP2) {
            PG8_LDB(B0, 0, 0); PG8_LDB(B1, 0, 1); PG8_SCHED; PG8_LDA(At, 0, 0); PG8_STAGE(PG8_SA(1, 1), a1 + hstep, voffA);
            PG8_WAIT_V(8); PG8_WAIT_L(0); PG8_BAR; PG8_MMA(0, 0, At, B0); PG8_MMA(0, 1, At, B1); PG8_BAR; PG8_SCHED;
            PG8_LDA(At, 0, 1); PG8_STAGE(PG8_SB(0, 0), b2, voffB); PG8_STAGE(PG8_SB(0, 1), b2 + hstep, voffB); PG8_STAGE(PG8_SA(0, 0), a2, voffA);
            PG8_WAIT_V(8); PG8_WAIT_L(0); PG8_BAR; PG8_MMA(1, 0, At, B0); PG8_MMA(1, 1, At, B1); PG8_BAR; PG8_SCHED;
            PG8_LDB(B0, 1, 0); PG8_LDB(B1, 1, 1); PG8_SCHED; PG8_LDA(At, 1, 0); PG8_STAGE(PG8_SA(0, 1), a2 + hstep, voffA);
            PG8_WAIT_V(8); PG8_WAIT_L(0); PG8_BAR; PG8_MMA(0, 0, At, B0); PG8_MMA(0, 1, At, B1); PG8_BAR; PG8_SCHED;
            PG8_LDA(At, 1, 1); PG8_STAGE(PG8_SB(1, 0), b3, voffB); PG8_STAGE(PG8_SB(1, 1), b3 + hstep, voffB); PG8_STAGE(PG8_SA(1, 0), a3, voffA);
            PG8_WAIT_V(8); PG8_WAIT_L(0); PG8_BAR; PG8_MMA(1, 0, At, B0); PG8_MMA(1, 1, At, B1); PG8_BAR; PG8_SCHED;
            } else {
            PG8_LDB(B0, 0, 0); PG8_SCHED; PG8_LDA(At, 0, 0); PG8_STAGE(PG8_SA(1, 1), a1 + hstep, voffA);
            PG8_WAIT_L(8); PG8_BAR; PG8_WAIT_L(0); PG8_MMA(0, 0, At, B0); PG8_BAR; PG8_SCHED;
            PG8_LDB(B1, 0, 1); PG8_STAGE(PG8_SB(0, 0), b2, voffB);
            PG8_BAR; PG8_WAIT_L(0); PG8_MMA(0, 1, At, B1); PG8_BAR;
            PG8_LDA(At, 0, 1); PG8_STAGE(PG8_SA(0, 0), a2, voffA);
            PG8_BAR; PG8_WAIT_L(0); PG8_MMA(1, 0, At, B0); PG8_BAR; PG8_SCHED;
            PG8_STAGE(PG8_SB(0, 1), b2 + hstep, voffB);
            PG8_WAIT_V(6); PG8_BAR; PG8_MMA(1, 1, At, B1); PG8_BAR;
            PG8_LDB(B0, 1, 0); PG8_SCHED; PG8_LDA(At, 1, 0); PG8_STAGE(PG8_SA(0, 1), a2 + hstep, voffA);
            PG8_WAIT_L(8); PG8_BAR; PG8_WAIT_L(0); PG8_MMA(0, 0, At, B0); PG8_BAR; PG8_SCHED;
            PG8_LDB(B1, 1, 1); PG8_STAGE(PG8_SB(1, 0), b3, voffB);
            PG8_BAR; PG8_WAIT_L(0); PG8_MMA(0, 1, At, B1); PG8_BAR;
            PG8_LDA(At, 1, 1); PG8_STAGE(PG8_SA(1, 0), a3, voffA);
            PG8_BAR; PG8_WAIT_L(0); PG8_MMA(1, 0, At, B0); PG8_BAR; PG8_SCHED;
            PG8_STAGE(PG8_SB(1, 1), b3 + hstep, voffB);
            PG8_WAIT_V(6); PG8_BAR; PG8_MMA(1, 1, At, B1); PG8_BAR;
            }
        }
        if constexpr (ALIGN_EPI) { if (wr == 0) PG8_BAR; }
        E(acc, cur, wr, wc, fr, fq);
        if (!has_next) break;
#pragma unroll
        for (int a = 0; a < 2; ++a)
#pragma unroll
            for (int b = 0; b < 2; ++b)
#pragma unroll
                for (int m = 0; m < 4; ++m)
#pragma unroll
                    for (int n = 0; n < 2; ++n) acc[a][b][m][n] = (f32x4){0.f, 0.f, 0.f, 0.f};
        cur = nxt; cA = nA; cB = nB; ++ui;
        if constexpr (ALIGN_EPI) { if (wr == 1) PG8_BAR; }
    }
    PG8_WAIT_V(0);
    if constexpr (!ALIGN_EPI) { if (wr == 0) PG8_BAR; }
    PG8_BAR;
#undef PG8_SA
#undef PG8_SB
#undef PG8_STAGE
#undef PG8_LDA
#undef PG8_LDB
#undef PG8_MMA
#undef PG8_WAIT_V
#undef PG8_WAIT_L
#undef PG8_BAR
#undef PG8_SCHED
}

typedef f32x4 Acc[2][2][4][2];

struct EpiP1 {
    bf16_t *QT, *KT, *V, *SG, *SQ, *SK, *SV, *KVM; float* ELAST;
    const float *LB, *qng, *kng, *rope;
    __device__ __forceinline__ void operator()(Acc& acc, const Unit& u, int wr, int wc, int fr, int fq) const {
        asm volatile("" : "+v"(fr), "+v"(fq));
        const int row0 = u.pm * BM + wr * 64 + fr;
        const int cw = wc * 32 + 8 * fq;
        if (u.kind == 1) {
#pragma unroll
            for (int ai = 0; ai < 2; ++ai)
#pragma unroll
                for (int m = 0; m < 4; ++m)
#pragma unroll
                    for (int bj = 0; bj < 2; ++bj) *(u32x4*)(KVM + (size_t)(row0 + ai * HALF + m * 16) * 1024 + u.pn * 256 + bj * HALF + cw) = pack8(acc[ai][bj][m][0], acc[ai][bj][m][1]);
            return;
        }
        const int pn = u.pn;
        if (pn < 4 && !(DIS_MASK & 1)) {
            const int hk0 = pn * 128 + cw;
            const f32x4 lb4[2] = {*(const f32x4*)(LB + hk0), *(const f32x4*)(LB + hk0 + 4)};
#pragma unroll
            for (int ai = 0; ai < 2; ++ai) {
                f32x4 el[2];
#pragma unroll
                for (int n = 0; n < 2; ++n)
#pragma unroll
                    for (int i = 0; i < 4; ++i) {
                        const float lbv = lb4[n][i], oml = 1.0f - lbv;
                        float carry = 1.f;
#pragma unroll
                        for (int m = 0; m < 4; ++m) {
                            float x = acc[ai][1][m][n][i]; x = fminf(fmaxf(x, -30.f), 30.f);
                            const float ex = fexp(-x), s = frcp(1.0f + ex);
                            const float f = lbv + oml * s, kk = oml * ex * s;
                            const float p = row16_prefix_mul(f);
                            const float eb = carry * p;
                            carry *= __shfl(p, 15, 16);
                            float qv = acc[ai][0][m][n][i] * eb, kv = kk * frcp(eb);
                            asm volatile("" : "+v"(qv), "+v"(kv));
                            acc[ai][0][m][n][i] = qv; acc[ai][1][m][n][i] = kv;
                        }
                        el[n][i] = carry;
                        __builtin_amdgcn_sched_barrier(0);
                    }
                if (fr == 0) { float* ep = ELAST + (size_t)(u.pm * 4 + ai * 2 + wr) * 512 + hk0; *(f32x4*)ep = el[0]; *(f32x4*)(ep + 4) = el[1]; }
#pragma unroll
                for (int m = 0; m < 4; ++m) { const size_t o = (size_t)(row0 + ai * HALF + m * 16) * 512 + hk0;
                    *(u32x4*)(QT + o) = pack8(acc[ai][0][m][0], acc[ai][0][m][1]); *(u32x4*)(KT + o) = pack8(acc[ai][1][m][0], acc[ai][1][m][1]); }
            }
        } else if (pn < 6) {
#pragma unroll
            for (int ai = 0; ai < 2; ++ai)
#pragma unroll
                for (int m = 0; m < 4; ++m)
#pragma unroll
                    for (int bj = 0; bj < 2; ++bj) *(u32x4*)(V + (size_t)(row0 + ai * HALF + m * 16) * 512 + (pn - 4) * 256 + bj * HALF + cw) = pack8(acc[ai][bj][m][0], acc[ai][bj][m][1]);
        } else if (pn < 8 && !(DIS_MASK & 2)) {
#pragma unroll
            for (int ai = 0; ai < 2; ++ai)
#pragma unroll
                for (int m = 0; m < 4; ++m)
#pragma unroll
                    for (int bj = 0; bj < 2; ++bj) { f32x4 a = acc[ai][bj][m][0], b = acc[ai][bj][m][1];
#pragma unroll
                        for (int i = 0; i < 4; ++i) { a[i] = a[i] * frcp(1.0f + fexp(-a[i])); b[i] = b[i] * frcp(1.0f + fexp(-b[i])); }
                        *(u32x4*)(SG + (size_t)(row0 + ai * HALF + m * 16) * 512 + (pn - 6) * 256 + bj * HALF + cw) = pack8(a, b); }
        } else {
            const bool isv = (pn == 10) && (wc >= 2);
            if (isv || (DIS_MASK & 4)) {
#pragma unroll
                for (int ai = 0; ai < 2; ++ai)
#pragma unroll
                    for (int m = 0; m < 4; ++m)
#pragma unroll
                        for (int bj = 0; bj < 2; ++bj) *(u32x4*)(SV + (size_t)(row0 + ai * HALF + m * 16) * 128 + (wc - 2) * 64 + bj * 32 + 8 * fq) = pack8(acc[ai][bj][m][0], acc[ai][bj][m][1]);
            } else {
                const bool isk = (pn == 10);
                const float* gp = isk ? kng : qng; const float osc = isk ? 1.0f : 0.125f * 1.4426950408889634f;
                f32x4 g[2][2];
#pragma unroll
                for (int bj = 0; bj < 2; ++bj)
#pragma unroll
                    for (int n = 0; n < 2; ++n) g[bj][n] = *(const f32x4*)(gp + bj * 32 + 8 * fq + 4 * n) * osc;
                bf16_t* ob = isk ? (SK + wc * 64 + 8 * fq) : (SQ + (pn - 8) * 256 + wc * 64 + 8 * fq); const int ld = isk ? 128 : 512;
#pragma unroll
                for (int ai = 0; ai < 2; ++ai)
#pragma unroll
                    for (int m = 0; m < 4; ++m) {
                        const int row = row0 + ai * HALF + m * 16;
                        float ss = 0.f;
#pragma unroll
                        for (int bj = 0; bj < 2; ++bj)
#pragma unroll
                            for (int n = 0; n < 2; ++n) { const f32x4 v = acc[ai][bj][m][n]; ss += (v[0] * v[0] + v[1] * v[1]) + (v[2] * v[2] + v[3] * v[3]); }
                        ss += __shfl_xor(ss, 16); ss += __shfl_xor(ss, 32);
                        const float rstd = frsq(ss * (1.0f / 64.0f) + EPS);
                        f32x4 y[2][2];
#pragma unroll
                        for (int bj = 0; bj < 2; ++bj)
#pragma unroll
                            for (int n = 0; n < 2; ++n) y[bj][n] = acc[ai][bj][m][n] * rstd * g[bj][n];
                        const float* rp = rope + (size_t)row * 16;
#pragma unroll
                        for (int n = 0; n < 2; ++n) {
                            const f32x4 cs = *(const f32x4*)(rp + 4 * n), sn = *(const f32x4*)(rp + 8 + 4 * n);
                            f32x4 o;
#pragma unroll
                            for (int i = 0; i < 4; ++i) { const float mine = y[0][n][i], oth = __shfl_xor(mine, 16);
                                const float r = (fq == 0) ? (mine * cs[i] - oth * sn[i]) : (mine * cs[i] + oth * sn[i]);
                                o[i] = (fq < 2) ? r : mine; }
                            y[0][n] = o;
                        }
#pragma unroll
                        for (int bj = 0; bj < 2; ++bj) *(u32x4*)(ob + (size_t)row * ld + bj * 32) = pack8(y[bj][0], y[bj][1]);
                    }
            }
        }
    }
};

template <bool BASE_BF16> struct EpiRes {
    const float* basef; const bf16_t* baseb; bf16_t* hb; float* sumsq;
    __device__ __forceinline__ void operator()(Acc& acc, const Unit& u, int wr, int wc, int fr, int fq) const {
        asm volatile("" : "+v"(fr), "+v"(fq));
        const int row0 = u.pm * BM + wr * 64 + fr, col0 = u.pn * BM + wc * 32 + 8 * fq;
        if constexpr (BASE_BF16) {
            u32x4 rw[2][4][2];
#pragma unroll
            for (int ai = 0; ai < 2; ++ai)
#pragma unroll
                for (int m = 0; m < 4; ++m)
#pragma unroll
                    for (int bj = 0; bj < 2; ++bj) rw[ai][m][bj] = *(const u32x4*)(baseb + (size_t)(row0 + ai * HALF + m * 16) * D + col0 + bj * HALF);
            __builtin_amdgcn_sched_barrier(0);
#pragma unroll
            for (int ai = 0; ai < 2; ++ai)
#pragma unroll
                for (int m = 0; m < 4; ++m) { const int row = row0 + ai * HALF + m * 16; const size_t o = (size_t)row * D + col0; float ss = 0.f;
#pragma unroll
                    for (int bj = 0; bj < 2; ++bj) { const u32x4 w = rw[ai][m][bj];
                        const f32x4 h0 = (f32x4){bflo(w.x), bfhi(w.x), bflo(w.y), bfhi(w.y)} + acc[ai][bj][m][0], h1 = (f32x4){bflo(w.z), bfhi(w.z), bflo(w.w), bfhi(w.w)} + acc[ai][bj][m][1];
                        *(u32x4*)(hb + o + bj * HALF) = pack8(h0, h1);
                        ss += (h0[0] * h0[0] + h0[1] * h0[1]) + (h0[2] * h0[2] + h0[3] * h0[3]) + (h1[0] * h1[0] + h1[1] * h1[1]) + (h1[2] * h1[2] + h1[3] * h1[3]); }
                    ss += __shfl_xor(ss, 16); ss += __shfl_xor(ss, 32);
                    if (fq == 0) atomicAdd(sumsq + row, ss); }
        } else {
#pragma unroll
            for (int ai = 0; ai < 2; ++ai) {
                f32x4 rx[4][2][2];
#pragma unroll
                for (int m = 0; m < 4; ++m)
#pragma unroll
                    for (int bj = 0; bj < 2; ++bj) { const float* p = basef + (size_t)(row0 + ai * HALF + m * 16) * D + col0 + bj * HALF; rx[m][bj][0] = *(const f32x4*)p; rx[m][bj][1] = *(const f32x4*)(p + 4); }
                __builtin_amdgcn_sched_barrier(0);
#pragma unroll
                for (int m = 0; m < 4; ++m) { const int row = row0 + ai * HALF + m * 16; const size_t o = (size_t)row * D + col0; float ss = 0.f;
#pragma unroll
                    for (int bj = 0; bj < 2; ++bj) { const f32x4 h0 = rx[m][bj][0] + acc[ai][bj][m][0], h1 = rx[m][bj][1] + acc[ai][bj][m][1];
                        *(u32x4*)(hb + o + bj * HALF) = pack8(h0, h1);
                        ss += (h0[0] * h0[0] + h0[1] * h0[1]) + (h0[2] * h0[2] + h0[3] * h0[3]) + (h1[0] * h1[0] + h1[1] * h1[1]) + (h1[2] * h1[2] + h1[3] * h1[3]); }
                    ss += __shfl_xor(ss, 16); ss += __shfl_xor(ss, 32);
                    if (fq == 0) atomicAdd(sumsq + row, ss); }
                __builtin_amdgcn_sched_barrier(0);
            }
        }
    }
};
template <int ACT> struct EpiScale {
    bf16_t* O; int ldc; const float* sumsq;
    __device__ __forceinline__ void operator()(Acc& acc, const Unit& u, int wr, int wc, int fr, int fq) const {
        asm volatile("" : "+v"(fr), "+v"(fq));
        const int row0 = u.pm * BM + wr * 64 + fr, col0 = u.pn * BM + wc * 32 + 8 * fq;
        float ssv[2][4];
        if (ACT == 0) {
#pragma unroll
            for (int ai = 0; ai < 2; ++ai)
#pragma unroll
                for (int m = 0; m < 4; ++m) ssv[ai][m] = sumsq[row0 + ai * HALF + m * 16];
            __builtin_amdgcn_sched_barrier(0);
        }
#pragma unroll
        for (int ai = 0; ai < 2; ++ai)
#pragma unroll
            for (int m = 0; m < 4; ++m) { const int row = row0 + ai * HALF + m * 16; const float rstd = (ACT == 0) ? frsq(ssv[ai][m] * (1.0f / D) + EPS) : 1.0f;
#pragma unroll
                for (int bj = 0; bj < 2; ++bj) { f32x4 a = acc[ai][bj][m][0] * rstd, b = acc[ai][bj][m][1] * rstd;
                    if (ACT == 1) {
#pragma unroll
                        for (int i = 0; i < 4; ++i) { const float x = fmaxf(a[i], 0.f), y = fmaxf(b[i], 0.f); a[i] = x * x; b[i] = y * y; } }
                    *(u32x4*)(O + (size_t)row * ldc + col0 + bj * HALF) = pack8(a, b); }
            }
    }
};
struct EpiAdd {
    const bf16_t* baseb; float* out; const float* sumsq;
    __device__ __forceinline__ void operator()(Acc& acc, const Unit& u, int wr, int wc, int fr, int fq) const {
        asm volatile("" : "+v"(fr), "+v"(fq));
        const int row0 = u.pm * BM + wr * 64 + fr, col0 = u.pn * BM + wc * 32 + 8 * fq;
        u32x4 rw[2][4][2]; float ssv[2][4];
#pragma unroll
        for (int ai = 0; ai < 2; ++ai)
#pragma unroll
            for (int m = 0; m < 4; ++m) { ssv[ai][m] = sumsq[row0 + ai * HALF + m * 16];
#pragma unroll
                for (int bj = 0; bj < 2; ++bj) rw[ai][m][bj] = *(const u32x4*)(baseb + (size_t)(row0 + ai * HALF + m * 16) * D + col0 + bj * HALF); }
        __builtin_amdgcn_sched_barrier(0);
#pragma unroll
        for (int ai = 0; ai < 2; ++ai)
#pragma unroll
            for (int m = 0; m < 4; ++m) { const size_t o_ = (size_t)(row0 + ai * HALF + m * 16) * D + col0; const float r2 = 1.0f / (ssv[ai][m] * (1.0f / D) + EPS);
#pragma unroll
                for (int bj = 0; bj < 2; ++bj) { const u32x4 w = rw[ai][m][bj];
                    const f32x4 h0 = (f32x4){bflo(w.x), bfhi(w.x), bflo(w.y), bfhi(w.y)} + acc[ai][bj][m][0] * r2, h1 = (f32x4){bflo(w.z), bfhi(w.z), bflo(w.w), bfhi(w.w)} + acc[ai][bj][m][1] * r2;
                    *(f32x4*)(out + o_ + bj * HALF) = h0; *(f32x4*)(out + o_ + bj * HALF + 4) = h1; } }
    }
};
}


#define XB_TMO      128
#define XB_XCNT(j)  (256  + 64 * (j))
#define XB_XSUB(j)  (1280 + 64 * (j))
#define XB_XGEN(j)  (2304 + 64 * (j))
#define XB_TOP      3328
#define XB_TOPGEN   3392
#define XB_SPIN_CAP (1u << 18)
__device__ __forceinline__ unsigned xb_ld(unsigned* p)              { return __hip_atomic_load(p, __ATOMIC_RELAXED, __HIP_MEMORY_SCOPE_AGENT); }
__device__ __forceinline__ unsigned xb_add(unsigned* p, unsigned v) { return __hip_atomic_fetch_add(p, v, __ATOMIC_RELAXED, __HIP_MEMORY_SCOPE_AGENT); }
__device__ __forceinline__ unsigned xb_xcc_id() { return (unsigned)__builtin_amdgcn_s_getreg((3 << 11) | 20) & 0xFu; }
#define XB_SPIN(cond, bar) do { unsigned _sp = 0; while (cond) { __builtin_amdgcn_s_sleep(1); \
    if ((++_sp & 255u) == 0u) { if (xb_ld(&(bar)[XB_TMO])) break; if (_sp > XB_SPIN_CAP) { atomicAdd(&(bar)[XB_TMO], 1u); break; } } } } while (0)
struct XcdBarrier { unsigned* bar; unsigned x; volatile LAS unsigned* st; };
__device__ __forceinline__ XcdBarrier xcd_barrier_post(unsigned* bar, volatile LAS unsigned* st) {
    XcdBarrier b; b.bar = bar; b.x = xb_xcc_id(); b.st = st;
    if (threadIdx.x == 0) st[2] = xb_add(&bar[XB_XCNT(b.x)], 1u);
    return b;
}
#define XB_LCNT(j)  (3456 + 64 * (j))
__device__ __forceinline__ void xcc_local_barrier(const XcdBarrier& b, unsigned nloc) {
    asm volatile("s_waitcnt vmcnt(0)" ::: "memory");
    __syncthreads();
    if (threadIdx.x == 0) {
        __builtin_amdgcn_s_waitcnt(0);
        const unsigned old = xb_add(&b.bar[XB_LCNT(b.x)], 1u);
        const unsigned target = (old / nloc + 1u) * nloc;
        XB_SPIN(xb_ld(&b.bar[XB_LCNT(b.x)]) < target, b.bar);
        __builtin_amdgcn_fence(__ATOMIC_ACQUIRE, "agent");
        asm volatile("s_waitcnt vmcnt(0)" ::: "memory");
    }
    __syncthreads();
}
__device__ __forceinline__ void xcd_barrier_complete(unsigned* bar, unsigned x, unsigned& nloc, unsigned& nx) {
    const unsigned G = gridDim.x * gridDim.y * gridDim.z;
    unsigned sum, cnt, mine, sp = 0u;
    for (;;) {
        sum = 0u; cnt = 0u; mine = 0u;
#pragma unroll
        for (unsigned j = 0; j < 16; ++j) { const unsigned c = xb_ld(&bar[XB_XCNT(j)]); sum += c; cnt += (c > 0u) ? 1u : 0u; mine = (j == x) ? c : mine; }
        if (sum == G) break;
        __builtin_amdgcn_s_sleep(1);
        if ((++sp & 255u) == 0u) { if (xb_ld(&bar[XB_TMO])) break; if (sp > XB_SPIN_CAP) { atomicAdd(&bar[XB_TMO], 1u); break; } }
    }
    nloc = mine > 0u ? mine : 1u; nx = cnt > 0u ? cnt : 1u;
}
#define XB_PRE(j)   (3968 + 8 * (j))
__device__ __forceinline__ void pre_arrive(const XcdBarrier& b) {
    asm volatile("s_waitcnt vmcnt(0)" ::: "memory");
    __syncthreads();
    if (threadIdx.x == 0) {
        __builtin_amdgcn_fence(__ATOMIC_RELEASE, "agent");
        asm volatile("s_waitcnt vmcnt(0)" ::: "memory");
        xb_add(&b.bar[XB_PRE(b.x)], 1u);
    }
}
__device__ __forceinline__ void pre_wait(const XcdBarrier& b) {
    if (threadIdx.x == 0) {
        const unsigned G = gridDim.x * gridDim.y * gridDim.z; unsigned sp = 0u;
        for (;;) { unsigned sum = 0u;
#pragma unroll
            for (unsigned j = 0; j < 16; ++j) sum += xb_ld(&b.bar[XB_PRE(j)]);
            if (sum == G) break;
            __builtin_amdgcn_s_sleep(1);
            if ((++sp & 255u) == 0u) { if (xb_ld(&b.bar[XB_TMO])) break; if (sp > XB_SPIN_CAP) { atomicAdd(&b.bar[XB_TMO], 1u); break; } } }
        __builtin_amdgcn_fence(__ATOMIC_ACQUIRE, "agent");
        asm volatile("s_waitcnt vmcnt(0)" ::: "memory");
    }
    __syncthreads();
}
__device__ __forceinline__ void xcd_barrier_arrive(const XcdBarrier& b) {
    asm volatile("s_waitcnt vmcnt(0)" ::: "memory");
    __syncthreads();
    if (threadIdx.x == 0) {
        unsigned* bar = b.bar;
        __builtin_amdgcn_s_waitcnt(0);
        unsigned nloc = b.st[0], nx = b.st[1];
        if (nloc == 0u) { xcd_barrier_complete(bar, b.x, nloc, nx); b.st[0] = nloc; b.st[1] = nx; }
        const unsigned old = xb_add(&bar[XB_XSUB(b.x)], 1u);
        const unsigned gen = old / nloc;
        if (old + 1u == (gen + 1u) * nloc) {
            __builtin_amdgcn_fence(__ATOMIC_RELEASE, "agent");
            asm volatile("s_waitcnt vmcnt(0)" ::: "memory");
            const unsigned og = xb_add(&bar[XB_TOP], 1u);
            const unsigned tg = og / nx;
            if (og + 1u == (tg + 1u) * nx) xb_add(&bar[XB_TOPGEN], 1u);
            else XB_SPIN(xb_ld(&bar[XB_TOPGEN]) == tg, bar);
            xb_add(&bar[XB_XGEN(b.x)], 1u);
            asm volatile("s_waitcnt vmcnt(0)" ::: "memory");
            b.st[5] = 1u;
        } else b.st[5] = 0u;
        b.st[4] = gen;
    }
}
__device__ __forceinline__ void xcd_barrier_wait(const XcdBarrier& b) {
    asm volatile("s_waitcnt vmcnt(0)" ::: "memory");
    __syncthreads();
    if (threadIdx.x == 0) {
        if (b.st[5] == 0u) { const unsigned gen = b.st[4]; XB_SPIN(xb_ld(&b.bar[XB_XGEN(b.x)]) == gen, b.bar); }
        __builtin_amdgcn_fence(__ATOMIC_ACQUIRE, "agent");
        asm volatile("s_waitcnt vmcnt(0)" ::: "memory");
    }
    __syncthreads();
}
__device__ __forceinline__ void xcd_barrier(const XcdBarrier& b) {
    asm volatile("s_waitcnt vmcnt(0)" ::: "memory");
    __syncthreads();
    if (threadIdx.x == 0) {
        unsigned* bar = b.bar;
        __builtin_amdgcn_s_waitcnt(0);
        unsigned nloc = b.st[0], nx = b.st[1];
        if (nloc == 0u) { xcd_barrier_complete(bar, b.x, nloc, nx); b.st[0] = nloc; b.st[1] = nx; }
        const unsigned old = xb_add(&bar[XB_XSUB(b.x)], 1u);
        const unsigned gen = old / nloc;
        if (old + 1u == (gen + 1u) * nloc) {
            __builtin_amdgcn_fence(__ATOMIC_RELEASE, "agent");
            asm volatile("s_waitcnt vmcnt(0)" ::: "memory");
            const unsigned og = xb_add(&bar[XB_TOP], 1u);
            const unsigned tg = og / nx;
            if (og + 1u == (tg + 1u) * nx) xb_add(&bar[XB_TOPGEN], 1u);
            else XB_SPIN(xb_ld(&bar[XB_TOPGEN]) == tg, bar);
            __builtin_amdgcn_fence(__ATOMIC_ACQUIRE, "agent");
            xb_add(&bar[XB_XGEN(b.x)], 1u);
            asm volatile("s_waitcnt vmcnt(0)" ::: "memory");
        } else {
            XB_SPIN(xb_ld(&bar[XB_XGEN(b.x)]) == gen, bar);
            __builtin_amdgcn_fence(__ATOMIC_ACQUIRE, "agent");
            asm volatile("s_waitcnt vmcnt(0)" ::: "memory");
        }
    }
    __syncthreads();
}

struct Args { const void* in[21]; float* out; unsigned char* ws; int ph_lo, ph_hi; };
struct Frame {
    LAS unsigned char* lds; int tid, lane, wave, G, bid;
    const float *x, *mem, *g1, *w_in, *hlb, *hng, *qng, *kng, *sinks, *w_out, *g2, *gm, *wq, *wkv, *xqg, *xkg, *wo, *g3, *wup, *wdn; const int* pos;
    float* out; unsigned char* ws;
};

__device__ __forceinline__ void p0_transpose_item(const float* W, int K, int N, bf16_t* WT, int dest_row0, const float* gain, LAS float* scr, int k0, int n0, int lane) {
    float wv[32];
#pragma unroll
    for (int i = 0; i < 32; ++i) { const int kk = 2 * i + (lane >> 5); wv[i] = W[(size_t)(k0 + kk) * N + n0 + (lane & 31)]; }
    if (gain) {
#pragma unroll
        for (int i = 0; i < 32; ++i) wv[i] *= gain[k0 + 2 * i + (lane >> 5)]; }
#pragma unroll
    for (int i = 0; i < 32; ++i) { const int kk = 2 * i + (lane >> 5); scr[kk * 33 + (lane & 31)] = wv[i]; }
    asm volatile("s_waitcnt lgkmcnt(0)" ::: "memory");
    const int c = lane & 7;
#pragma unroll
    for (int j = 0; j < 4; ++j) { const int n = (lane >> 3) + 8 * j; const LAS float* s = scr + (8 * c) * 33 + n;
        u32x4 o; o.x = pk2(s[0 * 33], s[1 * 33]); o.y = pk2(s[2 * 33], s[3 * 33]); o.z = pk2(s[4 * 33], s[5 * 33]); o.w = pk2(s[6 * 33], s[7 * 33]);
        *(u32x4*)(WT + (size_t)(dest_row0 + n) * K + k0 + 8 * c) = o; }
    asm volatile("s_waitcnt lgkmcnt(0)" ::: "memory");
}
__device__ __forceinline__ int win_dest(int c) {
    if (c < 512) return 256 * (c >> 7) + (c & 127);
    if (c < 1024) { const int cc = c - 512; return 256 * (cc >> 7) + 128 + (cc & 127); }
    if (c < 2048) return c;
    const int base = (c < 2560) ? 2048 + 256 * ((c - 2048) >> 8) : 2560;
    const int L = (c < 2560) ? ((c - 2048) & 255) : (c - 2560);
    const int wc = L >> 6, bj = (L & 63) >> 5;
    return base + 128 * bj + 32 * wc + (L & 31);
}
template <int NR> __device__ __forceinline__ void rms_rows_to_bf16(const float* x, const float* g, bf16_t* o, int row0, int rstride, int nrows, int lane) {
    f32x4 v[NR][4];
#pragma unroll
    for (int r = 0; r < NR; ++r) { const int rr = (row0 + r * rstride < nrows) ? row0 + r * rstride : row0; const f32x4* xr = (const f32x4*)(x + (size_t)rr * D) + lane;
#pragma unroll
        for (int j = 0; j < 4; ++j) v[r][j] = xr[64 * j]; }
    __builtin_amdgcn_sched_barrier(0);
    const f32x4* gr = (const f32x4*)g + lane;
    f32x4 gg[4];
#pragma unroll
    for (int j = 0; j < 4; ++j) gg[j] = gr[64 * j];
#pragma unroll
    for (int r = 0; r < NR; ++r) { float s = 0.f;
#pragma unroll
        for (int j = 0; j < 4; ++j) s += (v[r][j].x * v[r][j].x + v[r][j].y * v[r][j].y) + (v[r][j].z * v[r][j].z + v[r][j].w * v[r][j].w);
        const float rstd = 1.f / sqrtf(wave_sum(s) * (1.f / D) + EPS);
        if (row0 + r * rstride >= nrows) continue;
        u32x2* o8 = (u32x2*)(o + (size_t)(row0 + r * rstride) * D) + lane;
#pragma unroll
        for (int j = 0; j < 4; ++j) { u32x2 w; w.x = pk2(v[r][j].x * rstd * gg[j].x, v[r][j].y * rstd * gg[j].y); w.y = pk2(v[r][j].z * rstd * gg[j].z, v[r][j].w * rstd * gg[j].w); o8[64 * j] = w; } }
}
constexpr int I_IN = 16 * 88, I_KV = 16 * 32, I_OUT = 16 * 32, I_Q = 16 * 16, I_O = 8 * 32, I_UP = 16 * 128, I_DN = 64 * 32;
constexpr int ITEMS_EARLY = I_IN + I_KV, ITEMS_ALL = ITEMS_EARLY + I_OUT + I_Q + I_O + I_UP + I_DN;
__device__ __forceinline__ void transpose_items(Frame& F, int it0, int it1, int gw, int NGW) {
    LAS float* scr = (LAS float*)(F.lds + F.wave * 16384);
    bf16_t* Win_t = (bf16_t*)(F.ws + WS_WIN); bf16_t* Wout_t = (bf16_t*)(F.ws + WS_WOUT); bf16_t* Wq_t = (bf16_t*)(F.ws + WS_WQ); bf16_t* Wkv_t = (bf16_t*)(F.ws + WS_WKV);
    bf16_t* Wo_t = (bf16_t*)(F.ws + WS_WO); bf16_t* Wup_t = (bf16_t*)(F.ws + WS_WUP); bf16_t* Wdn_t = (bf16_t*)(F.ws + WS_WDN);
    for (int it = it0 + gw; it < it1; it += NGW) {
        int r = it;
        if (r < I_IN) { const int kb = r / 88, nb = r % 88; p0_transpose_item(F.w_in, D, INW, Win_t, win_dest(32 * nb), nullptr, scr, 64 * kb, 32 * nb, F.lane); continue; } r -= I_IN;
        if (r < I_KV) { const int kb = r / 32, nb = r % 32; p0_transpose_item(F.wkv, D, D, Wkv_t, 32 * nb, nullptr, scr, 64 * kb, 32 * nb, F.lane); continue; } r -= I_KV;
        if (r < I_OUT) { const int kb = r / 32, nb = r % 32; p0_transpose_item(F.w_out, D, D, Wout_t, 32 * nb, nullptr, scr, 64 * kb, 32 * nb, F.lane); continue; } r -= I_OUT;
        if (r < I_Q) { const int kb = r / 16, nb = r % 16; p0_transpose_item(F.wq, D, 512, Wq_t, 32 * nb, F.g2, scr, 64 * kb, 32 * nb, F.lane); continue; } r -= I_Q;
        if (r < I_O) { const int kb = r / 32, nb = r % 32; p0_transpose_item(F.wo, 512, D, Wo_t, 32 * nb, nullptr, scr, 64 * kb, 32 * nb, F.lane); continue; } r -= I_O;
        if (r < I_UP) { const int kb = r / 128, nb = r % 128; p0_transpose_item(F.wup, D, FF, Wup_t, 32 * nb, F.g3, scr, 64 * kb, 32 * nb, F.lane); continue; } r -= I_UP;
        { const int kb = r / 32, nb = r % 32; p0_transpose_item(F.wdn, FF, D, Wdn_t, 32 * nb, nullptr, scr, 64 * kb, 32 * nb, F.lane); }
    }
}
__device__ __forceinline__ void p0_main(Frame& F, int wb, int nw, bool all) {
    const int gw = wb * 8 + F.wave, NGW = nw * 8;
    transpose_items(F, 0, all ? ITEMS_ALL : I_IN, gw, NGW);
    bf16_t* HN1 = (bf16_t*)(F.ws + WS_HN1); bf16_t* MN = (bf16_t*)(F.ws + WS_MN);
    for (int m = gw; m < M; m += 4 * NGW) rms_rows_to_bf16<4>(F.x, F.g1, HN1, m, NGW, M, F.lane);
    if (all) for (int m = gw; m < MM; m += 2 * NGW) rms_rows_to_bf16<2>(F.mem, F.gm, MN, m, NGW, MM, F.lane);
    for (int e = wb * 512 + F.tid; e < 2 * 65536; e += nw * 512) ((float*)(F.ws + WS_SS2))[e] = 0.f;
    float* rope = (float*)(F.ws + WS_ROPE);
    for (int e = wb * 512 + F.tid; e < M * 8; e += nw * 512) { const int row = e >> 3, j = e & 7;
        const double inv_rev = (double)exp2f(-(float)j * (0.125f * 18.931568569324174f)) * 0.15915494309189535;
        const double rev = (double)F.pos[row] * inv_rev; const float fr = (float)(rev - rint(rev));
        rope[row * 16 + j] = __builtin_amdgcn_cosf(fr); rope[row * 16 + 8 + j] = __builtin_amdgcn_sinf(fr); }
    if (wb == 0) { float* LB = (float*)(F.ws + WS_LB); for (int k = F.tid; k < 512; k += 512) LB[k] = 1.0f / (1.0f + expf(F.hlb[512 + k] - F.hlb[k])); }
}

__device__ __forceinline__ void hgrn_simple(Frame& F, int b, int h) {
    LAS float* qs = (LAS float*)F.lds; LAS float* ks = qs + 64 * 128; LAS float* vs = ks + 64 * 128; LAS float* op = vs + 64 * 128;
    const bf16_t* QT = (const bf16_t*)(F.ws + WS_QT); const bf16_t* KT = (const bf16_t*)(F.ws + WS_KT); const bf16_t* V = (const bf16_t*)(F.ws + WS_V); const bf16_t* SG = (const bf16_t*)(F.ws + WS_SG);
    const float* ELAST = (const float*)(F.ws + WS_ELAST); bf16_t* MIX = (bf16_t*)(F.ws + WS_MIX);
    const int v = F.tid & 127, kg = F.tid >> 7;
    float S[32];
#pragma unroll
    for (int i = 0; i < 32; ++i) S[i] = 0.f;
    for (int c = 0; c < 32; ++c) {
        const int row0 = b * SEQ + c * 64;
        __syncthreads();
        for (int e = F.tid; e < 64 * 128; e += 512) { const int t = e >> 7, k = e & 127; const size_t o = (size_t)(row0 + t) * 512 + h * 128 + k;
            qs[e] = bf2f(QT[o]); ks[e] = bf2f(KT[o]); vs[e] = bf2f(V[o]); }
        __syncthreads();
        for (int tg = 0; tg < 4; ++tg) {
            for (int tt = 0; tt < 16; ++tt) { const int t = tg * 16 + tt; const float vv = vs[t * 128 + v]; float ao = 0.f;
#pragma unroll
                for (int kk = 0; kk < 32; ++kk) { S[kk] += ks[t * 128 + 32 * kg + kk] * vv; ao += S[kk] * qs[t * 128 + 32 * kg + kk]; }
                op[(kg * 16 + tt) * 128 + v] = ao; }
            __syncthreads();
#pragma unroll
            for (int rr = 0; rr < 2; ++rr) { const int tt = F.wave * 2 + rr, row = row0 + tg * 16 + tt;
                float o0 = 0.f, o1 = 0.f;
#pragma unroll
                for (int g = 0; g < 4; ++g) { o0 += op[(g * 16 + tt) * 128 + F.lane]; o1 += op[(g * 16 + tt) * 128 + F.lane + 64]; }
                const float rstd = 1.0f / sqrtf(wave_sum(o0 * o0 + o1 * o1) * (1.0f / 128.0f) + EPS);
                const size_t so = (size_t)row * 512 + h * 128;
                MIX[(size_t)row * 1024 + h * 128 + F.lane] = (bf16_t)f2bf(o0 * rstd * F.hng[F.lane] * bf2f(SG[so + F.lane]));
                MIX[(size_t)row * 1024 + h * 128 + F.lane + 64] = (bf16_t)f2bf(o1 * rstd * F.hng[F.lane + 64] * bf2f(SG[so + F.lane + 64])); }
            __syncthreads();
        }
        const float* el = ELAST + (size_t)(row0 >> 6) * 512 + h * 128 + 32 * kg;
#pragma unroll
        for (int kk = 0; kk < 32; ++kk) S[kk] *= el[kk];
    }
}
__device__ __forceinline__ void swa_simple(Frame& F, int row, int hq) {
    const bf16_t* SQ = (const bf16_t*)(F.ws + WS_SQ); const bf16_t* SK = (const bf16_t*)(F.ws + WS_SK); const bf16_t* SV = (const bf16_t*)(F.ws + WS_SV); bf16_t* MIX = (bf16_t*)(F.ws + WS_MIX);
    const int t = row & (SEQ - 1), kvh = hq >> 2, lane = F.lane;
    const float q = bf2f(SQ[(size_t)row * 512 + hq * 64 + lane]);
    const int nk = (t + 1 < 128) ? t + 1 : 128; const int r0 = row - nk + 1;
    float s0 = -INFINITY, s1 = -INFINITY;
    for (int j = 0; j < nk; ++j) { const float d = wave_sum(q * bf2f(SK[(size_t)(r0 + j) * 128 + kvh * 64 + lane]));
        if (lane == (j & 63)) { if (j < 64) s0 = d; else s1 = d; } }
    const float sink = F.sinks[hq] * 1.4426950408889634f;
    const float mx = fmaxf(wave_max(fmaxf(s0, s1)), sink);
    const float p0 = exp2f(s0 - mx), p1 = exp2f(s1 - mx);
    const float den = wave_sum(p0 + p1) + exp2f(sink - mx);
    float o = 0.f;
    for (int j = 0; j < nk; ++j) { const float p = __shfl(j < 64 ? p0 : p1, j & 63); o += p * bf2f(SV[(size_t)(r0 + j) * 128 + kvh * 64 + lane]); }
    MIX[(size_t)row * 1024 + 512 + hq * 64 + lane] = (bf16_t)f2bf(o / den);
}
__device__ __forceinline__ void kn_item(Frame& F, int item) {
    const bf16_t* KVM = (const bf16_t*)(F.ws + WS_KVM); bf16_t* KN = (bf16_t*)(F.ws + WS_KN);
    const int r = item >> 2, h = item & 3, lane = F.lane;
    const unsigned w = *(const unsigned*)(KVM + (size_t)r * 1024 + h * 128 + 2 * lane);
    const float a = bflo(w), b = bfhi(w);
    const float rstd = 1.0f / sqrtf(wave_sum(a * a + b * b) * (1.0f / 128.0f) + EPS);
    *(unsigned*)(KN + (size_t)r * 512 + h * 128 + 2 * lane) = pk2(a * rstd * F.xkg[2 * lane], b * rstd * F.xkg[2 * lane + 1]);
}
__device__ __forceinline__ void kn_items(Frame& F, int it0, int stride) {
    const bf16_t* KVM = (const bf16_t*)(F.ws + WS_KVM); bf16_t* KN = (bf16_t*)(F.ws + WS_KN);
    const int lane = F.lane; const float g0 = F.xkg[2 * lane], g1 = F.xkg[2 * lane + 1];
    for (int it = it0; it < MM * 4; it += 4 * stride) {
        unsigned w[4];
#pragma unroll
        for (int j = 0; j < 4; ++j) { const int item = it + j * stride; w[j] = (item < MM * 4) ? *(const unsigned*)(KVM + (size_t)(item >> 2) * 1024 + (item & 3) * 128 + 2 * lane) : 0u; }
        __builtin_amdgcn_sched_barrier(0);
#pragma unroll
        for (int j = 0; j < 4; ++j) { const int item = it + j * stride; const float a = bflo(w[j]), b = bfhi(w[j]);
            const float rstd = 1.0f / sqrtf(wave_sum(a * a + b * b) * (1.0f / 128.0f) + EPS);
            if (item < MM * 4) *(unsigned*)(KN + (size_t)(item >> 2) * 512 + (item & 3) * 128 + 2 * lane) = pk2(a * rstd * g0, b * rstd * g1); }
    }
}
__device__ __forceinline__ void xattn_simple(Frame& F, int row, int h) {
    const bf16_t* QX = (const bf16_t*)(F.ws + WS_QX); const bf16_t* KN = (const bf16_t*)(F.ws + WS_KN); const bf16_t* KVM = (const bf16_t*)(F.ws + WS_KVM); bf16_t* XO = (bf16_t*)(F.ws + WS_XO);
    const int b = row >> 11, lane = F.lane;
    const unsigned qw = *(const unsigned*)(QX + (size_t)row * 512 + h * 128 + 2 * lane);
    float q0 = bflo(qw), q1 = bfhi(qw);
    const float rstd = 1.0f / sqrtf(wave_sum(q0 * q0 + q1 * q1) * (1.0f / 128.0f) + EPS) * 0.08838834764831845f;
    q0 *= rstd * F.xqg[2 * lane]; q1 *= rstd * F.xqg[2 * lane + 1];
    float s[4] = {0.f, 0.f, 0.f, 0.f};
    for (int mm = 0; mm < 256; ++mm) { const unsigned kw = *(const unsigned*)(KN + (size_t)(b * 256 + mm) * 512 + h * 128 + 2 * lane);
        const float d = wave_sum(q0 * bflo(kw) + q1 * bfhi(kw));
        if (lane == (mm & 63)) {
#pragma unroll
            for (int g = 0; g < 4; ++g) if (g == (mm >> 6)) s[g] = d; } }
    const float mx = wave_max(fmaxf(fmaxf(s[0], s[1]), fmaxf(s[2], s[3])));
    float p[4]; float ps = 0.f;
#pragma unroll
    for (int g = 0; g < 4; ++g) { p[g] = __expf(s[g] - mx); ps += p[g]; }
    const float den = wave_sum(ps);
    float o0 = 0.f, o1 = 0.f;
#pragma unroll
    for (int g = 0; g < 4; ++g)
        for (int j = 0; j < 64; ++j) { const float pj = __shfl(p[g], j); const unsigned vw = *(const unsigned*)(KVM + (size_t)(b * 256 + g * 64 + j) * 1024 + 512 + h * 128 + 2 * lane);
            o0 += pj * bflo(vw); o1 += pj * bfhi(vw); }
    *(unsigned*)(XO + (size_t)row * 512 + h * 128 + 2 * lane) = pk2(o0 / den, o1 / den);
}


typedef float f32x16 __attribute__((ext_vector_type(16)));
typedef short s16x4 __attribute__((ext_vector_type(4)));
typedef short v4i16_t __attribute__((ext_vector_type(4)));
typedef float f32x2_t __attribute__((ext_vector_type(2)));
typedef __bf16 bf16x2_t __attribute__((ext_vector_type(2)));
#define MFMA32(a, b, c) __builtin_amdgcn_mfma_f32_32x32x16_bf16((a), (b), (c), 0, 0, 0)
__device__ __forceinline__ unsigned cvtpk(float lo, float hi) { f32x2_t v = {lo, hi}; bf16x2_t b = __builtin_convertvector(v, bf16x2_t); return __builtin_bit_cast(unsigned, b); }
__device__ __forceinline__ s16x4 ds_tr(const LAS unsigned char* p) { return __builtin_bit_cast(s16x4, __builtin_amdgcn_ds_read_tr16_b64_v4i16((LAS v4i16_t*)p)); }
__device__ __forceinline__ bf16x8 cat8(s16x4 lo, s16x4 hi) { return (bf16x8){lo[0], lo[1], lo[2], lo[3], hi[0], hi[1], hi[2], hi[3]}; }
__device__ __forceinline__ bf16x8 pack_step(const f32x16& x, int s) {
    u32x4 p; p.x = cvtpk(x[8 * s], x[8 * s + 1]); p.y = cvtpk(x[8 * s + 2], x[8 * s + 3]); p.z = cvtpk(x[8 * s + 4], x[8 * s + 5]); p.w = cvtpk(x[8 * s + 6], x[8 * s + 7]);
    return __builtin_bit_cast(bf16x8, p);
}
template <int RB> __device__ __forceinline__ unsigned offa(unsigned row, unsigned ch) { return RB * (row >> 3) + 512u * (ch >> 2) + 64u * (row & 7) + 16u * ((ch & 3) ^ ((row >> 2) & 3)); }

__device__ __forceinline__ void xattn_pair(Frame& F, int pair) {
    const bf16_t* QX = (const bf16_t*)(F.ws + WS_QX); const bf16_t* KN = (const bf16_t*)(F.ws + WS_KN); const bf16_t* KVM = (const bf16_t*)(F.ws + WS_KVM); bf16_t* XO = (bf16_t*)(F.ws + WS_XO);
    int lane = F.lane; asm volatile("" : "+v"(lane));
    const int bh = pair >> 2, b = bh >> 2, h = bh & 3, r32 = lane & 31, hi = lane >> 5;
    LAS unsigned char* Kimg = F.lds; LAS unsigned char* Vimg = F.lds + 65536; LAS unsigned char* stg = F.lds + 131072 + F.wave * 2560;
    __syncthreads();
    {
        u32x4 kt_[8], vt_[8];
#pragma unroll
        for (int it = 0; it < 8; ++it) { const int i = F.wave * 64 + lane + 512 * it, key = i >> 4, ch = i & 15;
            kt_[it] = *(const u32x4*)(KN + (size_t)(b * 256 + key) * 512 + h * 128 + 8 * ch);
            vt_[it] = *(const u32x4*)(KVM + (size_t)(b * 256 + key) * 1024 + 512 + h * 128 + 8 * ch); }
#pragma unroll
        for (int it = 0; it < 8; ++it) { const int i = F.wave * 64 + lane + 512 * it, key = i >> 4, ch = i & 15;
            *(LAS u32x4*)(Kimg + offa<2048>(key, ch)) = kt_[it]; *(LAS u32x4*)(Vimg + offa<2048>(key, ch)) = vt_[it]; }
    }
    __syncthreads();
    const float gqm = wave_max(fmaxf(fabsf(F.xqg[lane]), fabsf(F.xqg[lane + 64]))), gkm = wave_max(fmaxf(fabsf(F.xkg[lane]), fabsf(F.xkg[lane + 64])));
    const float C2 = 11.313708498984761f * gqm * gkm * 1.4426950408889634f;
    const unsigned kb = 2048u * (r32 >> 3) + 64u * (r32 & 7), xk = (r32 >> 2) & 3;
    const unsigned kbe = kb + 16u * ((unsigned)hi ^ xk), kbo = kb + 16u * ((2u + hi) ^ xk);
    const unsigned q4 = (lane & 15) >> 2, p4 = lane & 3, blk = (lane >> 4) & 1;
    const unsigned vb = 64u * (4 * hi + q4) + 8u * (p4 & 1), vc = 2 * blk + (p4 >> 1);
    const unsigned vb0 = vb + 16u * (vc ^ (unsigned)hi), vb1 = vb + 2048u + 16u * (vc ^ (2u + hi));
    for (int qq = 0; qq < 2; ++qq) {
        const int R0 = b * SEQ + ((pair & 3) * 2 + qq) * 256 + F.wave * 32;
        const bf16_t* qp = QX + (size_t)(R0 + r32) * 512 + h * 128 + 8 * hi;
        u32x4 qraw[8]; float ss = 0.f;
#pragma unroll
        for (int ks = 0; ks < 8; ++ks) { qraw[ks] = *(const u32x4*)(qp + 16 * ks);
#pragma unroll
            for (int j = 0; j < 4; ++j) { const float a = bflo(qraw[ks][j]), c = bfhi(qraw[ks][j]); ss += a * a + c * c; } }
        ss += __shfl_xor(ss, 32);
        const float sc = frsq(ss * (1.0f / 128.0f) + EPS) * (0.08838834764831845f * 1.4426950408889634f);
        bf16x8 qf[8];
#pragma unroll
        for (int ks = 0; ks < 8; ++ks) { const f32x4 g0 = *(const f32x4*)(F.xqg + 16 * ks + 8 * hi), g1 = *(const f32x4*)(F.xqg + 16 * ks + 8 * hi + 4);
            u32x4 w; w.x = cvtpk(bflo(qraw[ks].x) * sc * g0[0], bfhi(qraw[ks].x) * sc * g0[1]); w.y = cvtpk(bflo(qraw[ks].y) * sc * g0[2], bfhi(qraw[ks].y) * sc * g0[3]);
            w.z = cvtpk(bflo(qraw[ks].z) * sc * g1[0], bfhi(qraw[ks].z) * sc * g1[1]); w.w = cvtpk(bflo(qraw[ks].w) * sc * g1[2], bfhi(qraw[ks].w) * sc * g1[3]);
            qf[ks] = __builtin_bit_cast(bf16x8, w); }
        f32x16 o[4]; float lsum = 0.f;
#pragma unroll
        for (int c = 0; c < 4; ++c)
#pragma unroll
            for (int r = 0; r < 16; ++r) o[c][r] = 0.f;
        bf16x8 kf[8];
#pragma unroll
        for (int ks = 0; ks < 8; ++ks) kf[ks] = *(const LAS bf16x8*)(Kimg + ((ks & 1) ? kbo : kbe) + 512 * (ks >> 1));
        for (int kt = 0; kt < 8; ++kt) {
            const LAS unsigned char* Kn = Kimg + ((kt < 7) ? kt + 1 : kt) * 8192; const LAS unsigned char* Vt = Vimg + kt * 8192;
            f32x16 acc;
#pragma unroll
            for (int r = 0; r < 16; ++r) acc[r] = -C2;
#pragma unroll
            for (int ks = 0; ks < 8; ++ks) acc = MFMA32(kf[ks], qf[ks], acc);
            __builtin_amdgcn_sched_barrier(0);
            bf16x8 vf[2][4];
#pragma unroll
            for (int s = 0; s < 2; ++s)
#pragma unroll
                for (int c = 0; c < 4; ++c) vf[s][c] = cat8(ds_tr(Vt + s * 4096 + c * 512 + vb0), ds_tr(Vt + s * 4096 + c * 512 + vb1));
#pragma unroll
            for (int ks = 0; ks < 8; ++ks) kf[ks] = *(const LAS bf16x8*)(Kn + ((ks & 1) ? kbo : kbe) + 512 * (ks >> 1));
            __builtin_amdgcn_sched_barrier(0);
#pragma unroll
            for (int r = 0; r < 16; ++r) { acc[r] = __builtin_amdgcn_exp2f(acc[r]); lsum += acc[r]; }
            const bf16x8 pa0 = pack_step(acc, 0), pa1 = pack_step(acc, 1);
#pragma unroll
            for (int s = 0; s < 2; ++s)
#pragma unroll
                for (int c = 0; c < 4; ++c) o[c] = MFMA32(vf[s][c], s ? pa1 : pa0, o[c]);
        }
        lsum += __shfl_xor(lsum, 32);
        const float inv = frcp(lsum);
#pragma unroll
        for (int c = 0; c < 4; ++c) {
#pragma unroll
            for (int g = 0; g < 4; ++g) { u32x2 w; w.x = cvtpk(o[c][4 * g] * inv, o[c][4 * g + 1] * inv); w.y = cvtpk(o[c][4 * g + 2] * inv, o[c][4 * g + 3] * inv);
                *(LAS u32x2*)(stg + r32 * 80 + (8 * g + 4 * hi) * 2) = w; }
#pragma unroll
            for (int j = 0; j < 2; ++j) { const int idx = lane + 64 * j, row = idx >> 2, c8 = idx & 3;
                const u32x4 v = *(const LAS u32x4*)(stg + row * 80 + 16 * c8);
                *(u32x4*)(XO + (size_t)(R0 + row) * 512 + h * 128 + 32 * c + 8 * c8) = v; }
        }
    }
}

__device__ __forceinline__ void swa_unit(Frame& F, int u) {
    const bf16_t* SQ = (const bf16_t*)(F.ws + WS_SQ); const bf16_t* SK = (const bf16_t*)(F.ws + WS_SK); const bf16_t* SV = (const bf16_t*)(F.ws + WS_SV); bf16_t* MIX = (bf16_t*)(F.ws + WS_MIX);
    int lane = F.lane; asm volatile("" : "+v"(lane));
    const int b = u >> 5, n = (u >> 1) & 15, kvh = u & 1, r32 = lane & 31, hi = lane >> 5;
    LAS unsigned char* Kimg = F.lds; LAS unsigned char* Vimg = F.lds + 32768; LAS unsigned char* stg = F.lds + 65536 + F.wave * 4608;
    __syncthreads();
    {
        u32x4 kt_[4], vt_[4];
#pragma unroll
        for (int it = 0; it < 4; ++it) { const int i = F.wave * 64 + lane + 512 * it, key = i >> 3, ch = i & 7;
            const int keyl = (n > 0 || key >= 128) ? key : key + 128; const size_t row = (size_t)b * SEQ + (n - 1) * 128 + keyl;
            kt_[it] = *(const u32x4*)(SK + row * 128 + kvh * 64 + 8 * ch); vt_[it] = *(const u32x4*)(SV + row * 128 + kvh * 64 + 8 * ch); }
#pragma unroll
        for (int it = 0; it < 4; ++it) { const int i = F.wave * 64 + lane + 512 * it, key = i >> 3, ch = i & 7;
            *(LAS u32x4*)(Kimg + offa<1024>(key, ch)) = kt_[it]; *(LAS u32x4*)(Vimg + offa<1024>(key, ch)) = vt_[it]; }
    }
    __syncthreads();
    const int hq = kvh * 4 + (F.wave >> 1);
    const float gqm = wave_max(fabsf(F.qng[lane])), gkm = wave_max(fabsf(F.kng[lane]));
    const float sinkv = F.sinks[hq];
    const float C2 = fmaxf(8.0f * gqm * gkm, sinkv) * 1.4426950408889634f;
    const unsigned kb = 1024u * (r32 >> 3) + 64u * (r32 & 7), xk = (r32 >> 2) & 3;
    const unsigned kbe = kb + 16u * ((unsigned)hi ^ xk), kbo = kb + 16u * ((2u + hi) ^ xk);
    const unsigned q4 = (lane & 15) >> 2, p4 = lane & 3, blk = (lane >> 4) & 1;
    const unsigned vb = 64u * (4 * hi + q4) + 8u * (p4 & 1), vc = 2 * blk + (p4 >> 1);
    const unsigned vb0 = vb + 16u * (vc ^ (unsigned)hi), vb1 = vb + 1024u + 16u * (vc ^ (2u + hi));
    for (int aa = 0; aa < 2; ++aa) {
        const int a = (F.wave & 1) * 2 + aa;
        const int R0 = b * SEQ + n * 128 + 32 * a;
        const bf16_t* qp = SQ + (size_t)(R0 + r32) * 512 + hq * 64 + 8 * hi;
        bf16x8 qf[4];
#pragma unroll
        for (int ks = 0; ks < 4; ++ks) qf[ks] = *(const bf16x8*)(qp + 16 * ks);
        f32x16 o[2]; float lsum = 0.f;
#pragma unroll
        for (int c = 0; c < 2; ++c)
#pragma unroll
            for (int r = 0; r < 16; ++r) o[c][r] = 0.f;
        for (int j = 0; j < 5; ++j) {
            const int kt = a + j;
            if (n == 0 && kt < 4) continue;
            const LAS unsigned char* Kt = Kimg + kt * 4096; const LAS unsigned char* Vt = Vimg + kt * 4096;
            f32x16 acc;
#pragma unroll
            for (int r = 0; r < 16; ++r) acc[r] = -C2;
#pragma unroll
            for (int ks = 0; ks < 4; ++ks) { const bf16x8 kf = *(const LAS bf16x8*)(Kt + ((ks & 1) ? kbo : kbe) + 512 * (ks >> 1)); acc = MFMA32(kf, qf[ks], acc); }
#pragma unroll
            for (int r = 0; r < 16; ++r) { const int kl = (r & 3) + 8 * (r >> 2) + 4 * hi;
                const bool valid = (j == 0) ? (r32 < kl) : ((j == 4) ? (kl <= r32) : true);
                const float p = valid ? __builtin_amdgcn_exp2f(acc[r]) : 0.f; acc[r] = p; lsum += p; }
            const bf16x8 pa0 = pack_step(acc, 0), pa1 = pack_step(acc, 1);
#pragma unroll
            for (int s = 0; s < 2; ++s)
#pragma unroll
                for (int c = 0; c < 2; ++c) { const bf16x8 vf = cat8(ds_tr(Vt + s * 2048 + c * 512 + vb0), ds_tr(Vt + s * 2048 + c * 512 + vb1)); o[c] = MFMA32(vf, s ? pa1 : pa0, o[c]); }
        }
        lsum += __shfl_xor(lsum, 32);
        const float inv = frcp(lsum + __builtin_amdgcn_exp2f(sinkv * 1.4426950408889634f - C2));
#pragma unroll
        for (int c = 0; c < 2; ++c)
#pragma unroll
            for (int g = 0; g < 4; ++g) { u32x2 w; w.x = cvtpk(o[c][4 * g] * inv, o[c][4 * g + 1] * inv); w.y = cvtpk(o[c][4 * g + 2] * inv, o[c][4 * g + 3] * inv);
                *(LAS u32x2*)(stg + r32 * 144 + (32 * c + 8 * g + 4 * hi) * 2) = w; }
#pragma unroll
        for (int jj = 0; jj < 4; ++jj) { const int idx = lane + 64 * jj, row = idx >> 3, c8 = idx & 7;
            const u32x4 v = *(const LAS u32x4*)(stg + row * 144 + 16 * c8);
            *(u32x4*)(MIX + (size_t)(R0 + row) * 1024 + 512 + hq * 64 + 8 * c8) = v; }
    }
}


#define HG_BAR() asm volatile("s_waitcnt lgkmcnt(0)\n\ts_barrier" ::: "memory")
__device__ __forceinline__ void hgrn_mfma(Frame& F, int b, int h) {
    const bf16_t* QT = (const bf16_t*)(F.ws + WS_QT); const bf16_t* KT = (const bf16_t*)(F.ws + WS_KT); const bf16_t* V = (const bf16_t*)(F.ws + WS_V); const bf16_t* SG = (const bf16_t*)(F.ws + WS_SG);
    const float* ELAST = (const float*)(F.ws + WS_ELAST); bf16_t* MIX = (bf16_t*)(F.ws + WS_MIX);
    int lane = F.lane; asm volatile("" : "+v"(lane));
    const int r32 = lane & 31, hi = lane >> 5, w = F.wave, tid = w * 64 + lane;
    LAS unsigned char* img = F.lds;
    LAS unsigned char* pfrag = F.lds + 98304;
    LAS float* rowsq = (LAS float*)(F.lds + 104448);
    LAS float* elds = (LAS float*)(F.lds + 106496);
    LAS float* ngl = (LAS float*)(F.lds + 107520);
    LAS unsigned char* stg = F.lds + 108032 + (w & 3) * 5120;
    const size_t rbase = (size_t)b * SEQ; const int colh = h * 128;
    const unsigned q4 = (lane & 15) >> 2, p4 = lane & 3, blk = (lane >> 4) & 1, vc = 2 * blk + (p4 >> 1), p8 = 8u * (p4 & 1);
    const unsigned n0 = 2048u * hi + 64u * q4 + 16u * (vc ^ ((2u * hi) & 3u)) + p8, n1 = 2048u * hi + 64u * (4 + q4) + 16u * (vc ^ ((2u * hi + 1u) & 3u)) + p8;
    const unsigned k0 = 64u * (4 * hi + q4) + 16u * (vc ^ (unsigned)hi) + p8, k1 = 2048u + 64u * (4 * hi + q4) + 16u * (vc ^ (2u + hi)) + p8;
    const unsigned rb = 2048u * (r32 >> 3) + 64u * (r32 & 7), xr = (r32 >> 2) & 3;
    const unsigned rbe = rb + 16u * ((unsigned)hi ^ xr), rbo = rb + 16u * ((2u + hi) ^ xr);
    const unsigned qk00 = rb + 8u * hi + 16u * (0u ^ xr), qk01 = rb + 8u * hi + 16u * (1u ^ xr), qk10 = rb + 8u * hi + 16u * (2u ^ xr), qk11 = rb + 8u * hi + 16u * (3u ^ xr);
    __syncthreads();
#pragma unroll
    for (int i = 0; i < 6; ++i) { const int tensor = i >> 1, rem = tid + 512 * (i & 1), r = rem >> 4, ch = rem & 15;
        const bf16_t* src = (tensor == 0 ? QT : tensor == 1 ? KT : V) + (rbase + r) * 512 + colh + 8 * ch;
        *(LAS u32x4*)(img + tensor * 16384 + offa<2048>(r, ch)) = *(const u32x4*)src; }
    if (tid < 32) *(LAS f32x4*)(elds + 4 * tid) = *(const f32x4*)(ELAST + (rbase >> 6) * 512 + colh + 4 * tid);
    if (tid >= 64 && tid < 96) *(LAS f32x4*)(ngl + 4 * (tid - 64)) = *(const f32x4*)(F.hng + 4 * (tid - 64));
    __syncthreads();
    if (w < 4) {
        const int vb = w;
        f32x16 S[4];
#pragma unroll
        for (int kb = 0; kb < 4; ++kb)
#pragma unroll
            for (int r = 0; r < 16; ++r) S[kb][r] = 0.f;
        for (int c = 0; c < 32; ++c) {
            const LAS unsigned char* Qi = img + (c & 1) * 49152; const LAS unsigned char* Ki = Qi + 16384; const LAS unsigned char* Vi = Qi + 32768;
            const size_t row0 = rbase + 64 * c;
            f32x16 o[2];
#pragma unroll
            for (int tb = 0; tb < 2; ++tb)
#pragma unroll
                for (int r = 0; r < 16; ++r) o[tb][r] = 0.f;
#pragma unroll
            for (int kh = 0; kh < 2; ++kh) {
                u32x2 ql[2][2][2][2];
#pragma unroll
                for (int kl = 0; kl < 2; ++kl)
#pragma unroll
                    for (int s = 0; s < 2; ++s)
#pragma unroll
                        for (int tb = 0; tb < 2; ++tb) { const LAS unsigned char* qp = Qi + 8192 * tb + 512 * (2 * kh + kl);
                            ql[kl][s][tb][0] = *(const LAS u32x2*)(qp + (s ? qk10 : qk00)); ql[kl][s][tb][1] = *(const LAS u32x2*)(qp + (s ? qk11 : qk01)); }
                __builtin_amdgcn_sched_barrier(0);
#pragma unroll
                for (int kl = 0; kl < 2; ++kl)
#pragma unroll
                    for (int s = 0; s < 2; ++s) { const bf16x8 pa = pack_step(S[2 * kh + kl], s);
#pragma unroll
                        for (int tb = 0; tb < 2; ++tb) { const u32x4 qq = {ql[kl][s][tb][0].x, ql[kl][s][tb][0].y, ql[kl][s][tb][1].x, ql[kl][s][tb][1].y};
                            o[tb] = MFMA32(pa, __builtin_bit_cast(bf16x8, qq), o[tb]); } }
                __builtin_amdgcn_sched_barrier(0);
            }
            __builtin_amdgcn_sched_barrier(0);
#pragma unroll
            for (int ks = 0; ks < 4; ++ks) {
                const LAS unsigned char* vp = Vi + 4096 * ks + 512 * vb; const bf16x8 bfr = cat8(ds_tr(vp + n0), ds_tr(vp + n1)); bf16x8 af[4];
#pragma unroll
                for (int kb = 0; kb < 4; ++kb) { const LAS unsigned char* kp = Ki + 4096 * ks + 512 * kb; af[kb] = cat8(ds_tr(kp + n0), ds_tr(kp + n1)); }
                __builtin_amdgcn_sched_barrier(0);
#pragma unroll
                for (int kb = 0; kb < 4; ++kb) S[kb] = MFMA32(af[kb], bfr, S[kb]);
            }
            { const LAS float* ep = elds + (c & 1) * 128;
#pragma unroll
                for (int kb = 0; kb < 4; ++kb) { f32x4 e4[4];
#pragma unroll
                    for (int g = 0; g < 4; ++g) e4[g] = *(const LAS f32x4*)(ep + 32 * kb + 8 * g + 4 * hi);
#pragma unroll
                    for (int g = 0; g < 4; ++g)
#pragma unroll
                        for (int i = 0; i < 4; ++i) S[kb][4 * g + i] *= e4[g][i]; } }
            HG_BAR();
            {
                bf16x8 vf[2][2], pf[3][2];
#pragma unroll
                for (int sb = 0; sb < 2; ++sb)
#pragma unroll
                    for (int st = 0; st < 2; ++st) { const LAS unsigned char* vp = Vi + 8192 * sb + 4096 * st + 512 * vb; vf[sb][st] = cat8(ds_tr(vp + k0), ds_tr(vp + k1)); }
#pragma unroll
                for (int tl = 0; tl < 3; ++tl)
#pragma unroll
                    for (int st = 0; st < 2; ++st) pf[tl][st] = *(const LAS bf16x8*)(pfrag + (tl * 2 + st) * 1024 + lane * 16);
                __builtin_amdgcn_sched_barrier(0);
#pragma unroll
                for (int st = 0; st < 2; ++st) { o[0] = MFMA32(vf[0][st], pf[0][st], o[0]); o[1] = MFMA32(vf[0][st], pf[1][st], o[1]); o[1] = MFMA32(vf[1][st], pf[2][st], o[1]); }
            }
            f32x4 ng[4];
#pragma unroll
            for (int g = 0; g < 4; ++g) ng[g] = *(const LAS f32x4*)(ngl + 32 * vb + 8 * g + 4 * hi);
#pragma unroll
            for (int tb = 0; tb < 2; ++tb) { float ss = 0.f;
#pragma unroll
                for (int r = 0; r < 16; ++r) ss += o[tb][r] * o[tb][r];
                ss += __shfl_xor(ss, 32);
                if (hi == 0) rowsq[(c & 1) * 256 + vb * 64 + 32 * tb + r32] = ss;
#pragma unroll
                for (int g = 0; g < 4; ++g) { u32x2 v; v.x = cvtpk(o[tb][4 * g] * ng[g][0], o[tb][4 * g + 1] * ng[g][1]); v.y = cvtpk(o[tb][4 * g + 2] * ng[g][2], o[tb][4 * g + 3] * ng[g][3]);
                    *(LAS u32x2*)(stg + (c & 1) * 20480 + tb * 2560 + r32 * 80 + (8 * g + 4 * hi) * 2) = v; } }
            HG_BAR();
        }
    } else {
        const int ht = tid - 256, tile = w - 4, sb = (tile == 2) ? 1 : 0, tb = (tile == 0) ? 0 : 1;
        u32x4 sgp[2][2];
        auto hgrn_sgload = [&](int cc, int tb2) __attribute__((always_inline)) {
            const bf16_t* sgb = SG + (rbase + 64 * cc) * 512 + colh + 32 * (w - 4);
#pragma unroll
            for (int j = 0; j < 2; ++j) { const int idx = lane + 64 * j, row = idx >> 2, c8 = idx & 3, t = 32 * tb2 + row; sgp[tb2][j] = *(const u32x4*)(sgb + (unsigned)(t * 512 + 8 * c8)); }
        };
        auto hgrn_finalize = [&](int cc, int tb2) __attribute__((always_inline)) {
            const int vb = w - 4; const size_t row0 = rbase + 64 * cc;
            bf16_t* mxb = MIX + row0 * 1024 + colh + 32 * vb;
            const LAS float* rq = rowsq + (cc & 1) * 256; const LAS unsigned char* sb_ = stg + (cc & 1) * 20480 + tb2 * 2560;
#pragma unroll
            for (int j = 0; j < 2; ++j) { const int idx = lane + 64 * j, row = idx >> 2, c8 = idx & 3, t = 32 * tb2 + row;
                const u32x4 sg = sgp[tb2][j];
                const float rstd = frsq(((rq[t] + rq[64 + t]) + (rq[128 + t] + rq[192 + t])) * (1.0f / 128.0f) + EPS);
                const u32x4 a = *(const LAS u32x4*)(sb_ + row * 80 + c8 * 16);
                u32x4 ov; ov.x = cvtpk(bflo(a.x) * rstd * bflo(sg.x), bfhi(a.x) * rstd * bfhi(sg.x)); ov.y = cvtpk(bflo(a.y) * rstd * bflo(sg.y), bfhi(a.y) * rstd * bfhi(sg.y));
                ov.z = cvtpk(bflo(a.z) * rstd * bflo(sg.z), bfhi(a.z) * rstd * bfhi(sg.z)); ov.w = cvtpk(bflo(a.w) * rstd * bflo(sg.w), bfhi(a.w) * rstd * bfhi(sg.w));
                *(u32x4*)(mxb + (unsigned)(t * 1024 + 8 * c8)) = ov; }
        };
        for (int c = 0; c < 32; ++c) {
            const LAS unsigned char* Qi = img + (c & 1) * 49152; const LAS unsigned char* Ki = Qi + 16384;
            u32x4 tmp[12]; f32x4 etmp = {0.f, 0.f, 0.f, 0.f};
            const size_t nrow0 = rbase + 64 * ((c + 1 < 32) ? c + 1 : c);
            const unsigned ploff = (unsigned)(ht >> 4) * 512u + 8u * (unsigned)(ht & 15);
#pragma unroll
            for (int i = 0; i < 12; ++i) { const int tensor = i >> 2;
                const bf16_t* tb_ = (tensor == 0 ? QT : tensor == 1 ? KT : V) + nrow0 * 512 + colh + (i & 3) * 8192;
                tmp[i] = *(const u32x4*)(tb_ + ploff); }
            if (ht < 32) etmp = *(const f32x4*)(ELAST + (nrow0 >> 6) * 512 + colh + (unsigned)(4 * ht));
            if (c > 0) hgrn_finalize(c - 1, 0);
            hgrn_sgload(c, 0);
            if (w < 7) {
                f32x16 acc;
#pragma unroll
                for (int r = 0; r < 16; ++r) acc[r] = 0.f;
#pragma unroll
                for (int kh = 0; kh < 2; ++kh) {
                    bf16x8 kfr[4], qfr[4];
#pragma unroll
                    for (int kq = 0; kq < 4; ++kq) { const int ks = 4 * kh + kq; const unsigned o_ = ((ks & 1) ? rbo : rbe) + 512 * (ks >> 1); kfr[kq] = *(const LAS bf16x8*)(Ki + 8192 * sb + o_); qfr[kq] = *(const LAS bf16x8*)(Qi + 8192 * tb + o_); }
                    __builtin_amdgcn_sched_barrier(0);
#pragma unroll
                    for (int kq = 0; kq < 4; ++kq) acc = MFMA32(kfr[kq], qfr[kq], acc);
                    __builtin_amdgcn_sched_barrier(0);
                }
                if (sb == tb) {
#pragma unroll
                    for (int r = 0; r < 16; ++r) { const int sl = (r & 3) + 8 * (r >> 2) + 4 * hi; if (sl > r32) acc[r] = 0.f; } }
                *(LAS bf16x8*)(pfrag + (tile * 2 + 0) * 1024 + lane * 16) = pack_step(acc, 0);
                *(LAS bf16x8*)(pfrag + (tile * 2 + 1) * 1024 + lane * 16) = pack_step(acc, 1);
            }
            HG_BAR();
            if (c + 1 < 32) {
                LAS unsigned char* dst = img + ((c + 1) & 1) * 49152;
#pragma unroll
                for (int i = 0; i < 12; ++i) { const int tensor = i >> 2, rem = ht + 256 * (i & 3), r = rem >> 4, ch = rem & 15;
                    *(LAS u32x4*)(dst + tensor * 16384 + offa<2048>(r, ch)) = tmp[i]; }
                if (ht < 32) *(LAS f32x4*)(elds + ((c + 1) & 1) * 128 + 4 * ht) = etmp;
            }
            if (c > 0) hgrn_finalize(c - 1, 1);
            hgrn_sgload(c, 1);
            HG_BAR();
        }
        hgrn_finalize(31, 0); hgrn_finalize(31, 1);
    }
}

constexpr int NPHASE = 9;
__global__ void __launch_bounds__(512, 2) layer_fwd(Args args) {
    extern __shared__ __attribute__((aligned(16))) unsigned char lds_raw[];
    Frame F;
    F.lds = (LAS unsigned char*)lds_raw; F.tid = threadIdx.x; F.lane = F.tid & 63; F.wave = __builtin_amdgcn_readfirstlane(F.tid >> 6); F.G = gridDim.x; F.bid = blockIdx.x;
    F.x = (const float*)args.in[0]; F.mem = (const float*)args.in[1]; F.pos = (const int*)args.in[2]; F.g1 = (const float*)args.in[3]; F.w_in = (const float*)args.in[4];
    F.hlb = (const float*)args.in[5]; F.hng = (const float*)args.in[6]; F.qng = (const float*)args.in[7]; F.kng = (const float*)args.in[8]; F.sinks = (const float*)args.in[9];
    F.w_out = (const float*)args.in[10]; F.g2 = (const float*)args.in[11]; F.gm = (const float*)args.in[12]; F.wq = (const float*)args.in[13]; F.wkv = (const float*)args.in[14];
    F.xqg = (const float*)args.in[15]; F.xkg = (const float*)args.in[16]; F.wo = (const float*)args.in[17]; F.g3 = (const float*)args.in[18]; F.wup = (const float*)args.in[19]; F.wdn = (const float*)args.in[20];
    F.out = args.out; F.ws = args.ws;
    unsigned char* ws = args.ws;
    const int lo = args.ph_lo, hi = args.ph_hi;
#ifndef PH_MASK
#define PH_MASK 0x1ff
#endif
#define IN(k) (((PH_MASK >> (k)) & 1) && lo <= (k) && (k) < hi)
#ifndef GSYNC_SEAM
#define GSYNC_SEAM 0
#endif
    if (F.tid < 64) ((LAS unsigned*)(F.lds + LDSCTL_OFF))[F.tid] = 0u;
    __syncthreads();
    XcdBarrier xbar = xcd_barrier_post((unsigned*)(ws + WS_CTL) + 4096, (volatile LAS unsigned*)(F.lds + LDSCTL_OFF) + 8);
    int vb_ = F.bid; bool xl_ok = false;
#define LSEAM(k) do { if (IN(k) && IN((k) + 1)) { if (xl_ok) xcc_local_barrier(xbar, (unsigned)(F.G >> 3)); else xcd_barrier(xbar); } } while (0)
#define SEAM(k) do { if (IN(k) && IN((k) + 1)) { if ((k) == GSYNC_SEAM) cg::this_grid().sync(); else xcd_barrier(xbar); } } while (0)
    float* ss2 = (float*)(ws + WS_SS2); float* ss3 = (float*)(ws + WS_SS3);

#ifndef DUP_MASK
#define DUP_MASK 0
#endif
#define NREP(k) (1 + ((DUP_MASK >> (k)) & 1))
    const bool hsplit = F.G >= 128;
    pg8::EpiP1 EP1{(bf16_t*)(ws + WS_QT), (bf16_t*)(ws + WS_KT), (bf16_t*)(ws + WS_V), (bf16_t*)(ws + WS_SG), (bf16_t*)(ws + WS_SQ), (bf16_t*)(ws + WS_SK), (bf16_t*)(ws + WS_SV), (bf16_t*)(ws + WS_KVM),
                   (float*)(ws + WS_ELAST), (const float*)(ws + WS_LB), F.qng, F.kng, (const float*)(ws + WS_ROPE)};
    if (IN(0)) {
        if (!hsplit) p0_main(F, F.bid, F.G, true);
        else {
            const int gw = F.bid * 8 + F.wave, NGW = F.G * 8;
            transpose_items(F, I_IN, I_IN + I_KV, gw, NGW);
            for (int m = gw; m < MM; m += 2 * NGW) rms_rows_to_bf16<2>(F.mem, F.gm, (bf16_t*)(ws + WS_MN), m, NGW, MM, F.lane);
            pre_arrive(xbar);
            if (F.bid >= F.G - 64) {
                pre_wait(xbar);
                pg8::Sched S; S.A0 = (const char*)(ws + WS_HN1); S.B0 = (const char*)(ws + WS_WIN); S.A1 = (const char*)(ws + WS_MN); S.B1 = (const char*)(ws + WS_WKV);
                S.nM0 = M / 256; S.nN0 = 1; S.n0 = 0; S.n1 = (MM / 256) * 4; S.G = 64; S.c = F.bid - (F.G - 64); S.tstep = (size_t)256 * D * 2; S.nrep = 1;
                pg8::gemm_phase<pg8::EpiP1, true, true>(F.lds, D, S, EP1);
            } else p0_main(F, F.bid, F.G - 64, false);
        }
    }
    SEAM(0);
    if (IN(1)) {
        pg8::Sched S; S.A0 = (const char*)(ws + WS_HN1); S.B0 = (const char*)(ws + WS_WIN); S.A1 = (const char*)(ws + WS_MN); S.B1 = (const char*)(ws + WS_WKV);
        S.nM0 = M / 256; S.nN0 = hsplit ? 8 : INW / 256; S.n0 = S.nM0 * S.nN0; S.n1 = hsplit ? 0 : (MM / 256) * 4; S.G = F.G; S.c = F.bid; S.tstep = (size_t)256 * D * 2; S.nrep = 1;
        pg8::gemm_phase<pg8::EpiP1, true, true>(F.lds, D, S, EP1);
    }
    SEAM(1);
    if (IN(2)) {
        if (hsplit) {
            if (F.bid < 64) { xcd_barrier_arrive(xbar); hgrn_mfma(F, F.bid >> 2, F.bid & 3); xcd_barrier_wait(xbar); }
            else {
                pg8::Sched S; S.A0 = (const char*)(ws + WS_HN1); S.B0 = (const char*)(ws + WS_WIN); S.A1 = (const char*)(ws + WS_MN); S.B1 = (const char*)(ws + WS_WKV);
                S.nM0 = M / 256; S.nN0 = INW / 256 - 8; S.pnoff = 8; S.n0 = S.nM0 * S.nN0; S.n1 = 0; S.G = F.G - 64; S.c = F.bid - 64; S.tstep = (size_t)256 * D * 2; S.nrep = 1;
                pg8::gemm_phase<pg8::EpiP1, true, true>(F.lds, D, S, EP1);
                __syncthreads();
                const int nu = S.n0 + S.n1, rem = nu % S.G, nlt = (rem == 0) ? S.G : S.G - rem, lt0 = (rem == 0) ? 0 : rem;
                if (S.c >= lt0) transpose_items(F, ITEMS_EARLY, ITEMS_ALL, (S.c - lt0) * 8 + F.wave, nlt * 8);
                kn_items(F, (F.bid - 64) * 8 + F.wave, (F.G - 64) * 8);
                xcd_barrier(xbar);
            }
            for (int u = F.bid; u < 512; u += F.G) swa_unit(F, u);
        } else {
            for (int u = F.bid; u < 64; u += F.G) hgrn_mfma(F, (u & 63) >> 2, u & 3);
            __syncthreads();
            for (int u = F.bid; u < 512; u += F.G) swa_unit(F, u & 511);
        }
    }
    SEAM(2);
    {
        volatile LAS unsigned* st_ = (volatile LAS unsigned*)(F.lds + LDSCTL_OFF) + 8;
        if (F.tid == 0) { unsigned ok = ((F.G & 7) == 0) ? 1u : 0u; const unsigned per = (unsigned)(F.G >> 3);
            for (unsigned j = 0; j < 16; ++j) { const unsigned c_ = xb_ld(&xbar.bar[XB_XCNT(j)]); if (c_ != (j < 8 ? per : 0u)) ok = 0u; }
            st_[3] = ok; }
        __syncthreads();
        xl_ok = st_[3] != 0u;
        if (xl_ok) vb_ = (int)xbar.x + 8 * (int)st_[2];
    }
    if (IN(3)) {
        pg8::Sched S; S.A0 = (const char*)(ws + WS_MIX); S.B0 = (const char*)(ws + WS_WOUT); S.A1 = S.A0; S.B1 = S.B0;
        S.nM0 = M / 256; S.nN0 = 4; S.n0 = S.nM0 * 4; S.n1 = 0; S.G = F.G; S.c = vb_; S.tstep = (size_t)256 * D * 2; S.nrep = NREP(3);
        pg8::EpiRes<false> E{F.x, nullptr, (bf16_t*)(ws + WS_HB), ss2};
        pg8::gemm_phase<pg8::EpiRes<false>, true, true>(F.lds, D, S, E);
    }
    LSEAM(3);
    if (IN(4)) {
        if (F.G < 128) for (int it = F.bid * 8 + F.wave; it < MM * 4; it += F.G * 8) kn_item(F, it);
        pg8::Sched S; S.A0 = (const char*)(ws + WS_HB); S.B0 = (const char*)(ws + WS_WQ); S.A1 = S.A0; S.B1 = S.B0;
        S.nM0 = M / 256; S.nN0 = 2; S.n0 = S.nM0 * 2; S.n1 = 0; S.G = F.G; S.c = vb_; S.tstep = (size_t)256 * D * 2; S.nrep = NREP(4);
        pg8::EpiScale<0> E{(bf16_t*)(ws + WS_QX), 512, ss2};
        pg8::gemm_phase<pg8::EpiScale<0>, true, true>(F.lds, D, S, E);
    }
    LSEAM(4);
    if (IN(5)) {
        for (int pr = xl_ok ? ((vb_ & 7) * (F.G >> 3) + (vb_ >> 3)) : F.bid; pr < 256; pr += F.G) xattn_pair(F, pr);
    }
    LSEAM(5);
    if (IN(6)) {
        pg8::Sched S; S.A0 = (const char*)(ws + WS_XO); S.B0 = (const char*)(ws + WS_WO); S.A1 = S.A0; S.B1 = S.B0;
        S.nM0 = M / 256; S.nN0 = 4; S.n0 = S.nM0 * 4; S.n1 = 0; S.G = F.G; S.c = vb_; S.tstep = (size_t)256 * 512 * 2; S.nrep = NREP(6);
        pg8::EpiRes<true> E{nullptr, (const bf16_t*)(ws + WS_HB), (bf16_t*)(ws + WS_HB), ss3};
        pg8::gemm_phase<pg8::EpiRes<true>, true, true>(F.lds, 512, S, E);
    }
    LSEAM(6);
    if (IN(7)) {
        pg8::Sched S; S.A0 = (const char*)(ws + WS_HB); S.B0 = (const char*)(ws + WS_WUP); S.A1 = S.A0; S.B1 = S.B0;
        S.nM0 = M / 256; S.nN0 = 16; S.n0 = S.nM0 * 16; S.n1 = 0; S.G = F.G; S.c = vb_; S.tstep = (size_t)256 * D * 2; S.nrep = NREP(7);
        pg8::EpiScale<1> E{(bf16_t*)(ws + WS_ACT), FF, ss3};
        pg8::gemm_phase<pg8::EpiScale<1>, true, true>(F.lds, D, S, E);
    }
    LSEAM(7);
    if (IN(8)) {
        pg8::Sched S; S.A0 = (const char*)(ws + WS_ACT); S.B0 = (const char*)(ws + WS_WDN); S.A1 = S.A0; S.B1 = S.B0;
        S.nM0 = M / 256; S.nN0 = 4; S.n0 = S.nM0 * 4; S.n1 = 0; S.G = F.G; S.c = vb_; S.tstep = (size_t)256 * FF * 2; S.nrep = NREP(8);
        pg8::EpiAdd E{(const bf16_t*)(ws + WS_HB), F.out, ss3};
        pg8::gemm_phase<pg8::EpiAdd, true, true>(F.lds, FF, S, E);
    }
#undef IN
#undef SEAM
}

extern "C" void kernel_launch(void* const* d_in, const int* in_sizes, int n_in, void* d_out, int out_size, void* d_ws, size_t ws_size, hipStream_t stream) {
    static int grid = 0;
    if (grid == 0) {
        if (n_in != 21 || in_sizes[0] != M * D || out_size != M * D || ws_size < WS_END) { fprintf(stderr, "kernel_launch: unexpected shapes (n_in %d, ws %zu)\n", n_in, ws_size); grid = -1; return; }
        int dev = 0, cus = 0, per_cu = 0;
        (void)hipGetDevice(&dev); (void)hipDeviceGetAttribute(&cus, hipDeviceAttributeMultiprocessorCount, dev);
        (void)hipFuncSetAttribute((const void*)layer_fwd, hipFuncAttributeMaxDynamicSharedMemorySize, LDS_BYTES);
        (void)hipOccupancyMaxActiveBlocksPerMultiprocessor(&per_cu, (const void*)layer_fwd, 512, LDS_BYTES);
        if (per_cu < 1) per_cu = 1;
        if (per_cu > 1) per_cu = 1;
        grid = cus * per_cu; (void)hipGetLastError();
    }
    if (grid < 0) return;
    (void)hipMemsetAsync((char*)d_ws + WS_CTL, 0, CTL_ZERO_BYTES, stream);
    Args a{};
    for (int i = 0; i < 21; ++i) a.in[i] = d_in[i];
    a.out = (float*)d_out; a.ws = (unsigned char*)d_ws;
#if MK_N_LAUNCHES == 1
    a.ph_lo = 0; a.ph_hi = NPHASE;
    void* kargs[] = {&a};
    hipError_t e = hipLaunchCooperativeKernel((const void*)layer_fwd, dim3(grid), dim3(512), kargs, LDS_BYTES, stream);
    if (e != hipSuccess) fprintf(stderr, "cooperative launch failed: %s (grid %d)\n", hipGetErrorString(e), grid);
#else
    for (int p = 0; p < NPHASE; ++p) { a.ph_lo = p; a.ph_hi = p + 1; hipLaunchKernelGGL(layer_fwd, dim3(grid), dim3(512), LDS_BYTES, stream, a); }
#endif
}
```

```cpp
#include <hip/hip_runtime.h>
#include <hip/hip_cooperative_groups.h>
#include <cstdio>
#include <cstdint>
namespace cg = cooperative_groups;

#ifndef DIS_MASK
#define DIS_MASK 0
#endif
#ifndef MK_N_LAUNCHES
#define MK_N_LAUNCHES 1
#endif

#define LAS __attribute__((address_space(3)))
#define GAS __attribute__((address_space(1)))
typedef unsigned short bf16_t;
typedef short bf16x8 __attribute__((ext_vector_type(8)));
typedef float f32x4 __attribute__((ext_vector_type(4)));
typedef unsigned u32x4 __attribute__((ext_vector_type(4)));
typedef unsigned u32x2 __attribute__((ext_vector_type(2)));

constexpr int D = 1024, BATCH = 16, SEQ = 2048, M = BATCH * SEQ, MEMLEN = 256, MM = BATCH * MEMLEN;
constexpr int INW = 2816, FF = 4096;
constexpr float EPS = 1e-6f;

constexpr size_t MiB = 1u << 20;
constexpr size_t WS_CTL = 0, CTL_ZERO_BYTES = 64 * 1024;
constexpr size_t WS_SS2 = 1 * MiB, WS_SS3 = 1 * MiB + 256 * 1024;
constexpr size_t WS_LB = 1 * MiB + 512 * 1024;
constexpr size_t WS_WIN = 2 * MiB;
constexpr size_t WS_WOUT = WS_WIN + (size_t)INW * D * 2;
constexpr size_t WS_WQ = WS_WOUT + (size_t)D * D * 2;
constexpr size_t WS_WKV = WS_WQ + (size_t)512 * D * 2;
constexpr size_t WS_WO = WS_WKV + (size_t)D * D * 2;
constexpr size_t WS_WUP = WS_WO + (size_t)D * 512 * 2;
constexpr size_t WS_WDN = WS_WUP + (size_t)FF * D * 2;
constexpr size_t WS_ROPE = 30 * MiB;
constexpr size_t WS_KVM = 32 * MiB;
constexpr size_t WS_ELAST = 40 * MiB;
constexpr size_t WS_KN = 42 * MiB;
constexpr size_t WS_HB = 48 * MiB;
constexpr size_t WS_QX = 112 * MiB;
constexpr size_t WS_XO = 144 * MiB;
constexpr size_t WS_MIX = 176 * MiB;
constexpr size_t WS_R = 240 * MiB;
constexpr size_t WS_HN1 = WS_R;
constexpr size_t WS_MN = WS_R + 64 * MiB;
constexpr size_t WS_QT = WS_R + 72 * MiB;
constexpr size_t WS_KT = WS_R + 104 * MiB;
constexpr size_t WS_V = WS_R + 136 * MiB;
constexpr size_t WS_SG = WS_R + 168 * MiB;
constexpr size_t WS_SQ = WS_R + 200 * MiB;
constexpr size_t WS_SK = WS_R + 232 * MiB;
constexpr size_t WS_SV = WS_R + 240 * MiB;
constexpr size_t WS_ACT = WS_R;
constexpr size_t WS_END = WS_R + 256 * MiB;
static_assert(WS_WDN + (size_t)D * FF * 2 <= WS_ROPE, "weights fit");

constexpr int RING_BYTES = 131072, LDSCTL_OFF = 151552, LDS_BYTES = 155648;

__device__ __forceinline__ unsigned f2bf(float f) { unsigned u = __builtin_bit_cast(unsigned, f); return (u + 0x7fffu + ((u >> 16) & 1u)) >> 16; }
__device__ __forceinline__ unsigned pk2(float lo, float hi) { return f2bf(lo) | (f2bf(hi) << 16); }
__device__ __forceinline__ float bf2f(unsigned short b) { return __builtin_bit_cast(float, (unsigned)b << 16); }
__device__ __forceinline__ float bflo(unsigned w) { return __builtin_bit_cast(float, w << 16); }
__device__ __forceinline__ float bfhi(unsigned w) { return __builtin_bit_cast(float, w & 0xffff0000u); }
__device__ __forceinline__ unsigned cvt_pk_bf16(float lo, float hi) { unsigned r; asm volatile("v_cvt_pk_bf16_f32 %0, %1, %2" : "=v"(r) : "v"(lo), "v"(hi)); return r; }
__device__ __forceinline__ u32x4 pack8(const f32x4& a, const f32x4& b) { u32x4 w; w.x = cvt_pk_bf16(a[0], a[1]); w.y = cvt_pk_bf16(a[2], a[3]); w.z = cvt_pk_bf16(b[0], b[1]); w.w = cvt_pk_bf16(b[2], b[3]); return w; }
__device__ __forceinline__ float wave_sum(float v) {
#pragma unroll
    for (int o = 1; o < 64; o <<= 1) v += __shfl_xor(v, o);
    return v;
}
__device__ __forceinline__ float wave_max(float v) {
#pragma unroll
    for (int o = 1; o < 64; o <<= 1) v = fmaxf(v, __shfl_xor(v, o));
    return v;
}
__device__ __forceinline__ float fexp(float x) { return __builtin_amdgcn_exp2f(x * 1.4426950408889634f); }
__device__ __forceinline__ float frcp(float x) { return __builtin_amdgcn_rcpf(x); }
__device__ __forceinline__ float frsq(float x) { return __builtin_amdgcn_rsqf(x); }
__device__ __forceinline__ float flog(float x) { return __builtin_amdgcn_logf(x) * 0.6931471805599453f; }
template <int N> __device__ __forceinline__ float dpp_row_shr(float v) {
    return __builtin_bit_cast(float, __builtin_amdgcn_update_dpp(0, __builtin_bit_cast(int, v), 0x110 + N, 0xf, 0xf, false));
}
template <int N> __device__ __forceinline__ float dpp_row_shr1(float v) {
    return __builtin_bit_cast(float, __builtin_amdgcn_update_dpp(0x3f800000, __builtin_bit_cast(int, v), 0x110 + N, 0xf, 0xf, false));
}
__device__ __forceinline__ float row16_prefix_mul(float p) {
    p *= dpp_row_shr1<1>(p); p *= dpp_row_shr1<2>(p); p *= dpp_row_shr1<4>(p); p *= dpp_row_shr1<8>(p); return p;
}
__device__ __forceinline__ float row16_prefix(float p) {
    p += dpp_row_shr<1>(p); p += dpp_row_shr<2>(p); p += dpp_row_shr<4>(p); p += dpp_row_shr<8>(p); return p;
}

namespace pg8 {
constexpr int BM = 256, BK = 64, HALF = 128, HTB = HALF * BK * 2, NXCD = 8, WGM = 8;
__host__ __device__ __forceinline__ int lds_byte(int r, int c) { const int st = (r >> 4) * 2 + (c >> 5), rr = r & 15, cc = c & 31, ob = rr * 64 + cc * 2; return st * 1024 + (ob ^ (((ob >> 9) & 1) << 5)); }
__host__ __device__ __forceinline__ void stage_rc(int b, int& R, int& C) { const int st = b / 1024, sb = b % 1024, swz = sb ^ (((sb >> 9) & 1) << 5); R = (st >> 1) * 16 + swz / 64; C = (st & 1) * 32 + (swz % 64) / 2; }
__host__ __device__ __forceinline__ int perm32(int rho) { const int n = rho >> 4, i = rho & 15; return 8 * (i >> 2) + 4 * n + (i & 3); }

struct Unit { int pm, pn, kind; };
__device__ __forceinline__ void map_tile(int L, int nM, int nN, int& pm, int& pn) {
    const int nwg = nM * nN; int wgid = L;
    { const int q = nwg / NXCD, r = nwg % NXCD, xcd = wgid % NXCD, off = wgid / NXCD; wgid = (xcd < r ? xcd * (q + 1) : r * (q + 1) + (xcd - r) * q) + off; }
    const int nig = WGM * nN, gid = wgid / nig, fm = gid * WGM, gsz = (nM - fm) < WGM ? (nM - fm) : WGM;
    pm = fm + ((wgid % nig) % gsz); pn = (wgid % nig) / gsz;
}
struct Sched {
    const char *A0, *B0, *A1, *B1; int nM0, nN0, n0, n1, G, c; size_t tstep; int nrep; int pnoff = 0;
    __device__ __forceinline__ bool next(int i, Unit& u) const {
        int L = i * G + c;
        if (nrep > 1) { if (L < n0 * nrep) { const int pass = L / n0; map_tile(L - pass * n0, nM0, nN0, u.pm, u.pn); u.kind = (pass + 1 < nrep) ? 2 : 0; return true; } L -= n0 * (nrep - 1); }
        if (L < n0) { map_tile(L, nM0, nN0, u.pm, u.pn); u.pn += pnoff; u.kind = 0; return true; }
        if (L < n0 + n1) { const int idx = L - n0; u.pm = idx >> 2; u.pn = idx & 3; u.kind = 1; return true; }
        return false;
    }
    __device__ __forceinline__ const char* aptr(const Unit& u) const { return (u.kind == 1 ? A1 : A0) + (size_t)u.pm * tstep; }
    __device__ __forceinline__ const char* bptr(const Unit& u) const { return (u.kind == 1 ? B1 : B0) + (size_t)u.pn * tstep; }
};

template <class Epi, bool ALIGN_EPI, bool SP2>
__device__ __forceinline__ void gemm_phase(LAS unsigned char* lds, const int K, const Sched& S, const Epi& E) {
    const int tid = threadIdx.x, wid = __builtin_amdgcn_readfirstlane(tid >> 6), lane = tid & 63, wr = wid >> 2, wc = wid & 3, fr = lane & 15, fq = lane >> 4;
    const int nt = K / BK;
    unsigned voffA[2], voffB[2];
#pragma unroll
    for (int i = 0; i < 2; ++i) { int R, C; stage_rc(tid * 16 + i * 8192, R, C); const int Rb = (R & ~31) + perm32(R & 31);
        voffA[i] = (unsigned)(R * K + C) * 2u; voffB[i] = (unsigned)(Rb * K + C) * 2u; }
    const size_t kstep = (size_t)(BK * 2);
    const size_t hstep = (size_t)HALF * K * 2;
    const unsigned ldsw = (unsigned)wid * 1024u;
    const int aoff = lds_byte(wr * 64 + fr, fq * 8), boff = lds_byte(wc * 32 + fr, fq * 8);
#define PG8_SA(b, h) (((b) * 2 + (h)) * HTB)
#define PG8_SB(b, h) ((4 + (b) * 2 + (h)) * HTB)
#define PG8_STAGE(bufoff, gbase, voff) do { _Pragma("unroll") for (int _i = 0; _i < 2; ++_i) \
        __builtin_amdgcn_global_load_lds((const unsigned*)((const char*)(gbase) + (voff)[_i]), (LAS unsigned*)(lds + (bufoff) + ldsw + _i * 8192), 16, 0, 0); } while (0)
#define PG8_LDA(dst, b, h) do { _Pragma("unroll") for (int m = 0; m < 4; ++m) _Pragma("unroll") for (int k = 0; k < 2; ++k) dst[m][k] = *(const LAS bf16x8*)(lds + PG8_SA(b, h) + aoff + m * 2048 + k * 1024); } while (0)
#define PG8_LDB(dst, b, h) do { _Pragma("unroll") for (int n = 0; n < 2; ++n) _Pragma("unroll") for (int k = 0; k < 2; ++k) dst[n][k] = *(const LAS bf16x8*)(lds + PG8_SB(b, h) + boff + n * 2048 + k * 1024); } while (0)
#define PG8_MMA(ai, bj, At, Bt) do { __builtin_amdgcn_s_setprio(1); _Pragma("unroll") for (int m = 0; m < 4; ++m) _Pragma("unroll") for (int n = 0; n < 2; ++n) _Pragma("unroll") for (int k = 0; k < 2; ++k) \
        acc[ai][bj][m][n] = __builtin_amdgcn_mfma_f32_16x16x32_bf16(Bt[n][k], At[m][k], acc[ai][bj][m][n], 0, 0, 0); __builtin_amdgcn_s_setprio(0); } while (0)
#define PG8_WAIT_V(n) asm volatile("s_waitcnt vmcnt(" #n ")" ::: "memory")
#define PG8_WAIT_L(n) asm volatile("s_waitcnt lgkmcnt(" #n ")" ::: "memory")
#define PG8_BAR __builtin_amdgcn_s_barrier()
#define PG8_SCHED __builtin_amdgcn_sched_barrier(0)
    Unit cur, nxt; int ui = 0;
    if (!S.next(0, cur)) return;
    f32x4 acc[2][2][4][2];
#pragma unroll
    for (int a = 0; a < 2; ++a)
#pragma unroll
        for (int b = 0; b < 2; ++b)
#pragma unroll
            for (int m = 0; m < 4; ++m)
#pragma unroll
                for (int n = 0; n < 2; ++n) acc[a][b][m][n] = (f32x4){0.f, 0.f, 0.f, 0.f};
    bf16x8 At[4][2], B0[2][2], B1[2][2];
    const char* cA = S.aptr(cur); const char* cB = S.bptr(cur);
    if constexpr (SP2) {
        PG8_STAGE(PG8_SB(0, 0), cB, voffB); PG8_STAGE(PG8_SB(0, 1), cB + hstep, voffB); PG8_STAGE(PG8_SA(0, 0), cA, voffA); PG8_STAGE(PG8_SA(0, 1), cA + hstep, voffA);
        if (wr == 1) PG8_BAR;
        PG8_WAIT_V(2); PG8_BAR;
        PG8_STAGE(PG8_SB(1, 0), cB + kstep, voffB); PG8_STAGE(PG8_SA(1, 0), cA + kstep, voffA); PG8_STAGE(PG8_SB(1, 1), cB + hstep + kstep, voffB);
        PG8_WAIT_V(6); PG8_BAR;
    } else {
        PG8_STAGE(PG8_SB(0, 0), cB, voffB); PG8_STAGE(PG8_SA(0, 0), cA, voffA); PG8_STAGE(PG8_SB(0, 1), cB + hstep, voffB); PG8_STAGE(PG8_SA(0, 1), cA + hstep, voffA);
        if (wr == 1) PG8_BAR;
        PG8_WAIT_V(4); PG8_BAR;
        PG8_STAGE(PG8_SB(1, 0), cB + kstep, voffB); PG8_STAGE(PG8_SA(1, 0), cA + kstep, voffA); PG8_STAGE(PG8_SB(1, 1), cB + hstep + kstep, voffB);
        PG8_WAIT_V(6); PG8_BAR;
    }
    for (;;) {
        const bool has_next = S.next(ui + 1, nxt);
        const char* nA = has_next ? S.aptr(nxt) : cA; const char* nB = has_next ? S.bptr(nxt) : cB;
        for (int t = 0; t < nt; t += 2) {
            const bool last = (t == nt - 2);
            const char* a1 = cA + (size_t)(t + 1) * kstep;
            const char* a2 = last ? nA : cA + (size_t)(t + 2) * kstep; const char* b2 = last ? nB : cB + (size_t)(t + 2) * kstep;
            const char* a3 = a2 + kstep; const char* b3 = b2 + kstep;
            if constexpr (SP2) {
            PG8_LDB(B0, 0, 0); PG8_LDB(B1, 0, 1); PG8_SCHED; PG8_LDA(At, 0, 0); PG8_STAGE(PG8_SA(1, 1), a1 + hstep, voffA);
            PG8_WAIT_V(8); PG8_WAIT_L(0); PG8_BAR; PG8_MMA(0, 0, At, B0); PG8_MMA(0, 1, At, B1); PG8_BAR; PG8_SCHED;
            PG8_LDA(At, 0, 1); PG8_STAGE(PG8_SB(0, 0), b2, voffB); PG8_STAGE(PG8_SB(0, 1), b2 + hstep, voffB); PG8_STAGE(PG8_SA(0, 0), a2, voffA);
            PG8_WAIT_V(8); PG8_WAIT_L(0); PG8_BAR; PG8_MMA(1, 0, At, B0); PG8_MMA(1, 1, At, B1); PG8_BAR; PG8_SCHED;
            PG8_LDB(B0, 1, 0); PG8_LDB(B1, 1, 1); PG8_SCHED; PG8_LDA(At, 1, 0); PG8_STAGE(PG8_SA(0, 1), a2 + hstep, voffA);
            PG8_WAIT_V(8); PG8_WAIT_L(0); PG8_BAR; PG8_MMA(0, 0, At, B0); PG8_MMA(0, 1, At, B1); PG8_BAR; PG8_SCHED;
            PG8_LDA(At, 1, 1); PG8_STAGE(PG8_SB(1, 0), b3, voffB); PG8_STAGE(PG8_SB(1, 1), b3 + hstep, voffB); PG8_STAGE(PG8_SA(1, 0), a3, voffA);
            PG8_WAIT_V(8); PG8_WAIT_L(0); PG8_BAR; PG8_MMA(1, 0, At, B0); PG8_MMA(1, 1, At, B1); PG8_BAR; PG8_SCHED;
            } else {
            PG8_LDB(B0, 0, 0); PG8_SCHED; PG8_LDA(At, 0, 0); PG8_STAGE(PG8_SA(1, 1), a1 + hstep, voffA);
            PG8_WAIT_L(8); PG8_BAR; PG8_WAIT_L(0); PG8_MMA(0, 0, At, B0); PG8_BAR; PG8_SCHED;
            PG8_LDB(B1, 0, 1); PG8_STAGE(PG8_SB(0, 0), b2, voffB);
            PG8_BAR; PG8_WAIT_L(0); PG8_MMA(0, 1, At, B1); PG8_BAR;
            PG8_LDA(At, 0, 1); PG8_STAGE(PG8_SA(0, 0), a2, voffA);
            PG8_BAR; PG8_WAIT_L(0); PG8_MMA(1, 0, At, B0); PG8_BAR; PG8_SCHED;
            PG8_STAGE(PG8_SB(0, 1), b2 + hstep, voffB);
            PG8_WAIT_V(6); PG8_BAR; PG8_MMA(1, 1, At, B1); PG8_BAR;
            PG8_LDB(B0, 1, 0); PG8_SCHED; PG8_LDA(At, 1, 0); PG8_STAGE(PG8_SA(0, 1), a2 + hstep, voffA);
            PG8_WAIT_L(8); PG8_BAR; PG8_WAIT_L(0); PG8_MMA(0, 0, At, B0); PG8_BAR; PG8_SCHED;
            PG8_LDB(B1, 1, 1); PG8_STAGE(PG8_SB(1, 0), b3, voffB);
            PG8_BAR; PG8_WAIT_L(0); PG8_MMA(0, 1, At, B1); PG8_BAR;
            PG8_LDA(At, 1, 1); PG8_STAGE(PG8_SA(1, 0), a3, voffA);
            PG8_BAR; PG8_WAIT_L(0); PG8_MMA(1, 0, At, B0); PG8_BAR; PG8_SCHED;
            PG8_STAGE(PG8_SB(1, 1), b3 + hstep, voffB);
            PG8_WAIT_V(6); PG8_BAR; PG8_MMA(1, 1, At, B1); PG8_BAR;
            }
        }
        if constexpr (ALIGN_EPI) { if (wr == 0) PG8_BAR; }
        E(acc, cur, wr, wc, fr, fq);
        if (!has_next) break;
#pragma unroll
        for (int a = 0; a < 2; ++a)
#pragma unroll
            for (int b = 0; b < 2; ++b)
#pragma unroll
                for (int m = 0; m < 4; ++m)
#pragma unroll
                    for (int n = 0; n < 2; ++n) acc[a][b][m][n] = (f32x4){0.f, 0.f, 0.f, 0.f};
        cur = nxt; cA = nA; cB = nB; ++ui;
        if constexpr (ALIGN_EPI) { if (wr == 1) PG8_BAR; }
    }
    PG8_WAIT_V(0);
    if constexpr (!ALIGN_EPI) { if (wr == 0) PG8_BAR; }
    PG8_BAR;
#undef PG8_SA
#undef PG8_SB
#undef PG8_STAGE
#undef PG8_LDA
#undef PG8_LDB
#undef PG8_MMA
#undef PG8_WAIT_V
#undef PG8_WAIT_L
#undef PG8_BAR
#undef PG8_SCHED
}

typedef f32x4 Acc[2][2][4][2];

struct EpiP1 {
    bf16_t *QT, *KT, *V, *SG, *SQ, *SK, *SV, *KVM; float* ELAST;
    const float *LB, *qng, *kng, *rope;
    __device__ __forceinline__ void operator()(Acc& acc, const Unit& u, int wr, int wc, int fr, int fq) const {
        asm volatile("" : "+v"(fr), "+v"(fq));
        const int row0 = u.pm * BM + wr * 64 + fr;
        const int cw = wc * 32 + 8 * fq;
        if (u.kind == 1) {
#pragma unroll
            for (int ai = 0; ai < 2; ++ai)
#pragma unroll
                for (int m = 0; m < 4; ++m)
#pragma unroll
                    for (int bj = 0; bj < 2; ++bj) *(u32x4*)(KVM + (size_t)(row0 + ai * HALF + m * 16) * 1024 + u.pn * 256 + bj * HALF + cw) = pack8(acc[ai][bj][m][0], acc[ai][bj][m][1]);
            return;
        }
        const int pn = u.pn;
        if (pn < 4 && !(DIS_MASK & 1)) {
            const int hk0 = pn * 128 + cw;
            const f32x4 lb4[2] = {*(const f32x4*)(LB + hk0), *(const f32x4*)(LB + hk0 + 4)};
#pragma unroll
            for (int ai = 0; ai < 2; ++ai) {
                f32x4 el[2];
#pragma unroll
                for (int n = 0; n < 2; ++n)
#pragma unroll
                    for (int i = 0; i < 4; ++i) {
                        const float lbv = lb4[n][i], oml = 1.0f - lbv;
                        float carry = 1.f;
#pragma unroll
                        for (int m = 0; m < 4; ++m) {
                            float x = acc[ai][1][m][n][i]; x = fminf(fmaxf(x, -30.f), 30.f);
                            const float ex = fexp(-x), s = frcp(1.0f + ex);
                            const float f = lbv + oml * s, kk = oml * ex * s;
                            const float p = row16_prefix_mul(f);
                            const float eb = carry * p;
                            carry *= __shfl(p, 15, 16);
                            float qv = acc[ai][0][m][n][i] * eb, kv = kk * frcp(eb);
                            asm volatile("" : "+v"(qv), "+v"(kv));
                            acc[ai][0][m][n][i] = qv; acc[ai][1][m][n][i] = kv;
                        }
                        el[n][i] = carry;
                        __builtin_amdgcn_sched_barrier(0);
                    }
                if (fr == 0) { float* ep = ELAST + (size_t)(u.pm * 4 + ai * 2 + wr) * 512 + hk0; *(f32x4*)ep = el[0]; *(f32x4*)(ep + 4) = el[1]; }
#pragma unroll
                for (int m = 0; m < 4; ++m) { const size_t o = (size_t)(row0 + ai * HALF + m * 16) * 512 + hk0;
                    *(u32x4*)(QT + o) = pack8(acc[ai][0][m][0], acc[ai][0][m][1]); *(u32x4*)(KT + o) = pack8(acc[ai][1][m][0], acc[ai][1][m][1]); }
            }
        } else if (pn < 6) {
#pragma unroll
            for (int ai = 0; ai < 2; ++ai)
#pragma unroll
                for (int m = 0; m < 4; ++m)
#pragma unroll
                    for (int bj = 0; bj < 2; ++bj) *(u32x4*)(V + (size_t)(row0 + ai * HALF + m * 16) * 512 + (pn - 4) * 256 + bj * HALF + cw) = pack8(acc[ai][bj][m][0], acc[ai][bj][m][1]);
        } else if (pn < 8 && !(DIS_MASK & 2)) {
#pragma unroll
            for (int ai = 0; ai < 2; ++ai)
#pragma unroll
                for (int m = 0; m < 4; ++m)
#pragma unroll
                    for (int bj = 0; bj < 2; ++bj) { f32x4 a = acc[ai][bj][m][0], b = acc[ai][bj][m][1];
#pragma unroll
                        for (int i = 0; i < 4; ++i) { a[i] = a[i] * frcp(1.0f + fexp(-a[i])); b[i] = b[i] * frcp(1.0f + fexp(-b[i])); }
                        *(u32x4*)(SG + (size_t)(row0 + ai * HALF + m * 16) * 512 + (pn - 6) * 256 + bj * HALF + cw) = pack8(a, b); }
        } else {
            const bool isv = (pn == 10) && (wc >= 2);
            if (isv || (DIS_MASK & 4)) {
#pragma unroll
                for (int ai = 0; ai < 2; ++ai)
#pragma unroll
                    for (int m = 0; m < 4; ++m)
#pragma unroll
                        for (int bj = 0; bj < 2; ++bj) *(u32x4*)(SV + (size_t)(row0 + ai * HALF + m * 16) * 128 + (wc - 2) * 64 + bj * 32 + 8 * fq) = pack8(acc[ai][bj][m][0], acc[ai][bj][m][1]);
            } else {
                const bool isk = (pn == 10);
                const float* gp = isk ? kng : qng; const float osc = isk ? 1.0f : 0.125f * 1.4426950408889634f;
                f32x4 g[2][2];
#pragma unroll
                for (int bj = 0; bj < 2; ++bj)
#pragma unroll
                    for (int n = 0; n < 2; ++n) g[bj][n] = *(const f32x4*)(gp + bj * 32 + 8 * fq + 4 * n) * osc;
                bf16_t* ob = isk ? (SK + wc * 64 + 8 * fq) : (SQ + (pn - 8) * 256 + wc * 64 + 8 * fq); const int ld = isk ? 128 : 512;
#pragma unroll
                for (int ai = 0; ai < 2; ++ai)
#pragma unroll
                    for (int m = 0; m < 4; ++m) {
                        const int row = row0 + ai * HALF + m * 16;
                        float ss = 0.f;
#pragma unroll
                        for (int bj = 0; bj < 2; ++bj)
#pragma unroll
                            for (int n = 0; n < 2; ++n) { const f32x4 v = acc[ai][bj][m][n]; ss += (v[0] * v[0] + v[1] * v[1]) + (v[2] * v[2] + v[3] * v[3]); }
                        ss += __shfl_xor(ss, 16); ss += __shfl_xor(ss, 32);
                        const float rstd = frsq(ss * (1.0f / 64.0f) + EPS);
                        f32x4 y[2][2];
#pragma unroll
                        for (int bj = 0; bj < 2; ++bj)
#pragma unroll
                            for (int n = 0; n < 2; ++n) y[bj][n] = acc[ai][bj][m][n] * rstd * g[bj][n];
                        const float* rp = rope + (size_t)row * 16;
#pragma unroll
                        for (int n = 0; n < 2; ++n) {
                            const f32x4 cs = *(const f32x4*)(rp + 4 * n), sn = *(const f32x4*)(rp + 8 + 4 * n);
                            f32x4 o;
#pragma unroll
                            for (int i = 0; i < 4; ++i) { const float mine = y[0][n][i], oth = __shfl_xor(mine, 16);
                                const float r = (fq == 0) ? (mine * cs[i] - oth * sn[i]) : (mine * cs[i] + oth * sn[i]);
                                o[i] = (fq < 2) ? r : mine; }
                            y[0][n] = o;
                        }
#pragma unroll
                        for (int bj = 0; bj < 2; ++bj) *(u32x4*)(ob + (size_t)row * ld + bj * 32) = pack8(y[bj][0], y[bj][1]);
                    }
            }
        }
    }
};

template <bool BASE_BF16> struct EpiRes {
    const float* basef; const bf16_t* baseb; bf16_t* hb; float* sumsq;
    __device__ __forceinline__ void operator()(Acc& acc, const Unit& u, int wr, int wc, int fr, int fq) const {
        asm volatile("" : "+v"(fr), "+v"(fq));
        const int row0 = u.pm * BM + wr * 64 + fr, col0 = u.pn * BM + wc * 32 + 8 * fq;
        if constexpr (BASE_BF16) {
            u32x4 rw[2][4][2];
#pragma unroll
            for (int ai = 0; ai < 2; ++ai)
#pragma unroll
                for (int m = 0; m < 4; ++m)
#pragma unroll
                    for (int bj = 0; bj < 2; ++bj) rw[ai][m][bj] = *(const u32x4*)(baseb + (size_t)(row0 + ai * HALF + m * 16) * D + col0 + bj * HALF);
            __builtin_amdgcn_sched_barrier(0);
#pragma unroll
            for (int ai = 0; ai < 2; ++ai)
#pragma unroll
                for (int m = 0; m < 4; ++m) { const int row = row0 + ai * HALF + m * 16; const size_t o = (size_t)row * D + col0; float ss = 0.f;
#pragma unroll
                    for (int bj = 0; bj < 2; ++bj) { const u32x4 w = rw[ai][m][bj];
                        const f32x4 h0 = (f32x4){bflo(w.x), bfhi(w.x), bflo(w.y), bfhi(w.y)} + acc[ai][bj][m][0], h1 = (f32x4){bflo(w.z), bfhi(w.z), bflo(w.w), bfhi(w.w)} + acc[ai][bj][m][1];
                        *(u32x4*)(hb + o + bj * HALF) = pack8(h0, h1);
                        ss += (h0[0] * h0[0] + h0[1] * h0[1]) + (h0[2] * h0[2] + h0[3] * h0[3]) + (h1[0] * h1[0] + h1[1] * h1[1]) + (h1[2] * h1[2] + h1[3] * h1[3]); }
                    ss += __shfl_xor(ss, 16); ss += __shfl_xor(ss, 32);
                    if (fq == 0) atomicAdd(sumsq + row, ss); }
        } else {
#pragma unroll
            for (int ai = 0; ai < 2; ++ai) {
                f32x4 rx[4][2][2];
#pragma unroll
                for (int m = 0; m < 4; ++m)
#pragma unroll
                    for (int bj = 0; bj < 2; ++bj) { const float* p = basef + (size_t)(row0 + ai * HALF + m * 16) * D + col0 + bj * HALF; rx[m][bj][0] = *(const f32x4*)p; rx[m][bj][1] = *(const f32x4*)(p + 4); }
                __builtin_amdgcn_sched_barrier(0);
#pragma unroll
                for (int m = 0; m < 4; ++m) { const int row = row0 + ai * HALF + m * 16; const size_t o = (size_t)row * D + col0; float ss = 0.f;
#pragma unroll
                    for (int bj = 0; bj < 2; ++bj) { const f32x4 h0 = rx[m][bj][0] + acc[ai][bj][m][0], h1 = rx[m][bj][1] + acc[ai][bj][m][1];
                        *(u32x4*)(hb + o + bj * HALF) = pack8(h0, h1);
                        ss += (h0[0] * h0[0] + h0[1] * h0[1]) + (h0[2] * h0[2] + h0[3] * h0[3]) + (h1[0] * h1[0] + h1[1] * h1[1]) + (h1[2] * h1[2] + h1[3] * h1[3]); }
                    ss += __shfl_xor(ss, 16); ss += __shfl_xor(ss, 32);
                    if (fq == 0) atomicAdd(sumsq + row, ss); }
                __builtin_amdgcn_sched_barrier(0);
            }
        }
    }
};
template <int ACT> struct EpiScale {
    bf16_t* O; int ldc; const float* sumsq;
    __device__ __forceinline__ void operator()(Acc& acc, const Unit& u, int wr, int wc, int fr, int fq) const {
        asm volatile("" : "+v"(fr), "+v"(fq));
        const int row0 = u.pm * BM + wr * 64 + fr, col0 = u.pn * BM + wc * 32 + 8 * fq;
        float ssv[2][4];
        if (ACT == 0) {
#pragma unroll
            for (int ai = 0; ai < 2; ++ai)
#pragma unroll
                for (int m = 0; m < 4; ++m) ssv[ai][m] = sumsq[row0 + ai * HALF + m * 16];
            __builtin_amdgcn_sched_barrier(0);
        }
#pragma unroll
        for (int ai = 0; ai < 2; ++ai)
#pragma unroll
            for (int m = 0; m < 4; ++m) { const int row = row0 + ai * HALF + m * 16; const float rstd = (ACT == 0) ? frsq(ssv[ai][m] * (1.0f / D) + EPS) : 1.0f;
#pragma unroll
                for (int bj = 0; bj < 2; ++bj) { f32x4 a = acc[ai][bj][m][0] * rstd, b = acc[ai][bj][m][1] * rstd;
                    if (ACT == 1) {
#pragma unroll
                        for (int i = 0; i < 4; ++i) { const float x = fmaxf(a[i], 0.f), y = fmaxf(b[i], 0.f); a[i] = x * x; b[i] = y * y; } }
                    *(u32x4*)(O + (size_t)row * ldc + col0 + bj * HALF) = pack8(a, b); }
            }
    }
};
struct EpiAdd {
    const bf16_t* baseb; float* out; const float* sumsq;
    __device__ __forceinline__ void operator()(Acc& acc, const Unit& u, int wr, int wc, int fr, int fq) const {
        asm volatile("" : "+v"(fr), "+v"(fq));
        const int row0 = u.pm * BM + wr * 64 + fr, col0 = u.pn * BM + wc * 32 + 8 * fq;
        u32x4 rw[2][4][2]; float ssv[2][4];
#pragma unroll
        for (int ai = 0; ai < 2; ++ai)
#pragma unroll
            for (int m = 0; m < 4; ++m) { ssv[ai][m] = sumsq[row0 + ai * HALF + m * 16];
#pragma unroll
                for (int bj = 0; bj < 2; ++bj) rw[ai][m][bj] = *(const u32x4*)(baseb + (size_t)(row0 + ai * HALF + m * 16) * D + col0 + bj * HALF); }
        __builtin_amdgcn_sched_barrier(0);
#pragma unroll
        for (int ai = 0; ai < 2; ++ai)
#pragma unroll
            for (int m = 0; m < 4; ++m) { const size_t o_ = (size_t)(row0 + ai * HALF + m * 16) * D + col0; const float r2 = 1.0f / (ssv[ai][m] * (1.0f / D) + EPS);
#pragma unroll
                for (int bj = 0; bj < 2; ++bj) { const u32x4 w = rw[ai][m][bj];
                    const f32x4 h0 = (f32x4){bflo(w.x), bfhi(w.x), bflo(w.y), bfhi(w.y)} + acc[ai][bj][m][0] * r2, h1 = (f32x4){bflo(w.z), bfhi(w.z), bflo(w.w), bfhi(w.w)} + acc[ai][bj][m][1] * r2;
                    *(f32x4*)(out + o_ + bj * HALF) = h0; *(f32x4*)(out + o_ + bj * HALF + 4) = h1; } }
    }
};
}


#define XB_TMO      128
#define XB_XCNT(j)  (256  + 64 * (j))
#define XB_XSUB(j)  (1280 + 64 * (j))
#define XB_XGEN(j)  (2304 + 64 * (j))
#define XB_TOP      3328
#define XB_TOPGEN   3392
#define XB_SPIN_CAP (1u << 18)
__device__ __forceinline__ unsigned xb_ld(unsigned* p)              { return __hip_atomic_load(p, __ATOMIC_RELAXED, __HIP_MEMORY_SCOPE_AGENT); }
__device__ __forceinline__ unsigned xb_add(unsigned* p, unsigned v) { return __hip_atomic_fetch_add(p, v, __ATOMIC_RELAXED, __HIP_MEMORY_SCOPE_AGENT); }
__device__ __forceinline__ unsigned xb_xcc_id() { return (unsigned)__builtin_amdgcn_s_getreg((3 << 11) | 20) & 0xFu; }
#define XB_SPIN(cond, bar) do { unsigned _sp = 0; while (cond) { __builtin_amdgcn_s_sleep(1); \
    if ((++_sp & 255u) == 0u) { if (xb_ld(&(bar)[XB_TMO])) break; if (_sp > XB_SPIN_CAP) { atomicAdd(&(bar)[XB_TMO], 1u); break; } } } } while (0)
struct XcdBarrier { unsigned* bar; unsigned x; volatile LAS unsigned* st; };
__device__ __forceinline__ XcdBarrier xcd_barrier_post(unsigned* bar, volatile LAS unsigned* st) {
    XcdBarrier b; b.bar = bar; b.x = xb_xcc_id(); b.st = st;
    if (threadIdx.x == 0) st[2] = xb_add(&bar[XB_XCNT(b.x)], 1u);
    return b;
}
#define XB_LCNT(j)  (3456 + 64 * (j))
__device__ __forceinline__ void xcc_local_barrier(const XcdBarrier& b, unsigned nloc) {
    asm volatile("s_waitcnt vmcnt(0)" ::: "memory");
    __syncthreads();
    if (threadIdx.x == 0) {
        __builtin_amdgcn_s_waitcnt(0);
        const unsigned old = xb_add(&b.bar[XB_LCNT(b.x)], 1u);
        const unsigned target = (old / nloc + 1u) * nloc;
        XB_SPIN(xb_ld(&b.bar[XB_LCNT(b.x)]) < target, b.bar);
        __builtin_amdgcn_fence(__ATOMIC_ACQUIRE, "agent");
        asm volatile("s_waitcnt vmcnt(0)" ::: "memory");
    }
    __syncthreads();
}
__device__ __forceinline__ void xcd_barrier_complete(unsigned* bar, unsigned x, unsigned& nloc, unsigned& nx) {
    const unsigned G = gridDim.x * gridDim.y * gridDim.z;
    unsigned sum, cnt, mine, sp = 0u;
    for (;;) {
        sum = 0u; cnt = 0u; mine = 0u;
#pragma unroll
        for (unsigned j = 0; j < 16; ++j) { const unsigned c = xb_ld(&bar[XB_XCNT(j)]); sum += c; cnt += (c > 0u) ? 1u : 0u; mine = (j == x) ? c : mine; }
        if (sum == G) break;
        __builtin_amdgcn_s_sleep(1);
        if ((++sp & 255u) == 0u) { if (xb_ld(&bar[XB_TMO])) break; if (sp > XB_SPIN_CAP) { atomicAdd(&bar[XB_TMO], 1u); break; } }
    }
    nloc = mine > 0u ? mine : 1u; nx = cnt > 0u ? cnt : 1u;
}
__device__ __forceinline__ void xcd_barrier_arrive(const XcdBarrier& b) {
    asm volatile("s_waitcnt vmcnt(0)" ::: "memory");
    __syncthreads();
    if (threadIdx.x == 0) {
        unsigned* bar = b.bar;
        __builtin_amdgcn_s_waitcnt(0);
        unsigned nloc = b.st[0], nx = b.st[1];
        if (nloc == 0u) { xcd_barrier_complete(bar, b.x, nloc, nx); b.st[0] = nloc; b.st[1] = nx; }
        const unsigned old = xb_add(&bar[XB_XSUB(b.x)], 1u);
        const unsigned gen = old / nloc;
        if (old + 1u == (gen + 1u) * nloc) {
            __builtin_amdgcn_fence(__ATOMIC_RELEASE, "agent");
            asm volatile("s_waitcnt vmcnt(0)" ::: "memory");
            const unsigned og = xb_add(&bar[XB_TOP], 1u);
            const unsigned tg = og / nx;
            if (og + 1u == (tg + 1u) * nx) xb_add(&bar[XB_TOPGEN], 1u);
            else XB_SPIN(xb_ld(&bar[XB_TOPGEN]) == tg, bar);
            xb_add(&bar[XB_XGEN(b.x)], 1u);
            asm volatile("s_waitcnt vmcnt(0)" ::: "memory");
            b.st[5] = 1u;
        } else b.st[5] = 0u;
        b.st[4] = gen;
    }
}
__device__ __forceinline__ void xcd_barrier_wait(const XcdBarrier& b) {
    asm volatile("s_waitcnt vmcnt(0)" ::: "memory");
    __syncthreads();
    if (threadIdx.x == 0) {
        if (b.st[5] == 0u) { const unsigned gen = b.st[4]; XB_SPIN(xb_ld(&b.bar[XB_XGEN(b.x)]) == gen, b.bar); }
        __builtin_amdgcn_fence(__ATOMIC_ACQUIRE, "agent");
        asm volatile("s_waitcnt vmcnt(0)" ::: "memory");
    }
    __syncthreads();
}
__device__ __forceinline__ void xcd_barrier(const XcdBarrier& b) {
    asm volatile("s_waitcnt vmcnt(0)" ::: "memory");
    __syncthreads();
    if (threadIdx.x == 0) {
        unsigned* bar = b.bar;
        __builtin_amdgcn_s_waitcnt(0);
        unsigned nloc = b.st[0], nx = b.st[1];
        if (nloc == 0u) { xcd_barrier_complete(bar, b.x, nloc, nx); b.st[0] = nloc; b.st[1] = nx; }
        const unsigned old = xb_add(&bar[XB_XSUB(b.x)], 1u);
        const unsigned gen = old / nloc;
        if (old + 1u == (gen + 1u) * nloc) {
            __builtin_amdgcn_fence(__ATOMIC_RELEASE, "agent");
            asm volatile("s_waitcnt vmcnt(0)" ::: "memory");
            const unsigned og = xb_add(&bar[XB_TOP], 1u);
            const unsigned tg = og / nx;
            if (og + 1u == (tg + 1u) * nx) xb_add(&bar[XB_TOPGEN], 1u);
            else XB_SPIN(xb_ld(&bar[XB_TOPGEN]) == tg, bar);
            __builtin_amdgcn_fence(__ATOMIC_ACQUIRE, "agent");
            xb_add(&bar[XB_XGEN(b.x)], 1u);
            asm volatile("s_waitcnt vmcnt(0)" ::: "memory");
        } else {
            XB_SPIN(xb_ld(&bar[XB_XGEN(b.x)]) == gen, bar);
            __builtin_amdgcn_fence(__ATOMIC_ACQUIRE, "agent");
            asm volatile("s_waitcnt vmcnt(0)" ::: "memory");
        }
    }
    __syncthreads();
}

struct Args { const void* in[21]; float* out; unsigned char* ws; int ph_lo, ph_hi; };
struct Frame {
    LAS unsigned char* lds; int tid, lane, wave, G, bid;
    const float *x, *mem, *g1, *w_in, *hlb, *hng, *qng, *kng, *sinks, *w_out, *g2, *gm, *wq, *wkv, *xqg, *xkg, *wo, *g3, *wup, *wdn; const int* pos;
    float* out; unsigned char* ws;
};

__device__ __forceinline__ void p0_transpose_item(const float* W, int K, int N, bf16_t* WT, int dest_row0, const float* gain, LAS float* scr, int k0, int n0, int lane) {
    float wv[32];
#pragma unroll
    for (int i = 0; i < 32; ++i) { const int kk = 2 * i + (lane >> 5); wv[i] = W[(size_t)(k0 + kk) * N + n0 + (lane & 31)]; }
    if (gain) {
#pragma unroll
        for (int i = 0; i < 32; ++i) wv[i] *= gain[k0 + 2 * i + (lane >> 5)]; }
#pragma unroll
    for (int i = 0; i < 32; ++i) { const int kk = 2 * i + (lane >> 5); scr[kk * 33 + (lane & 31)] = wv[i]; }
    asm volatile("s_waitcnt lgkmcnt(0)" ::: "memory");
    const int c = lane & 7;
#pragma unroll
    for (int j = 0; j < 4; ++j) { const int n = (lane >> 3) + 8 * j; const LAS float* s = scr + (8 * c) * 33 + n;
        u32x4 o; o.x = pk2(s[0 * 33], s[1 * 33]); o.y = pk2(s[2 * 33], s[3 * 33]); o.z = pk2(s[4 * 33], s[5 * 33]); o.w = pk2(s[6 * 33], s[7 * 33]);
        *(u32x4*)(WT + (size_t)(dest_row0 + n) * K + k0 + 8 * c) = o; }
    asm volatile("s_waitcnt lgkmcnt(0)" ::: "memory");
}
__device__ __forceinline__ int win_dest(int c) {
    if (c < 512) return 256 * (c >> 7) + (c & 127);
    if (c < 1024) { const int cc = c - 512; return 256 * (cc >> 7) + 128 + (cc & 127); }
    if (c < 2048) return c;
    const int base = (c < 2560) ? 2048 + 256 * ((c - 2048) >> 8) : 2560;
    const int L = (c < 2560) ? ((c - 2048) & 255) : (c - 2560);
    const int wc = L >> 6, bj = (L & 63) >> 5;
    return base + 128 * bj + 32 * wc + (L & 31);
}
template <int NR> __device__ __forceinline__ void rms_rows_to_bf16(const float* x, const float* g, bf16_t* o, int row0, int rstride, int nrows, int lane) {
    f32x4 v[NR][4];
#pragma unroll
    for (int r = 0; r < NR; ++r) { const int rr = (row0 + r * rstride < nrows) ? row0 + r * rstride : row0; const f32x4* xr = (const f32x4*)(x + (size_t)rr * D) + lane;
#pragma unroll
        for (int j = 0; j < 4; ++j) v[r][j] = xr[64 * j]; }
    __builtin_amdgcn_sched_barrier(0);
    const f32x4* gr = (const f32x4*)g + lane;
    f32x4 gg[4];
#pragma unroll
    for (int j = 0; j < 4; ++j) gg[j] = gr[64 * j];
#pragma unroll
    for (int r = 0; r < NR; ++r) { float s = 0.f;
#pragma unroll
        for (int j = 0; j < 4; ++j) s += (v[r][j].x * v[r][j].x + v[r][j].y * v[r][j].y) + (v[r][j].z * v[r][j].z + v[r][j].w * v[r][j].w);
        const float rstd = 1.f / sqrtf(wave_sum(s) * (1.f / D) + EPS);
        if (row0 + r * rstride >= nrows) continue;
        u32x2* o8 = (u32x2*)(o + (size_t)(row0 + r * rstride) * D) + lane;
#pragma unroll
        for (int j = 0; j < 4; ++j) { u32x2 w; w.x = pk2(v[r][j].x * rstd * gg[j].x, v[r][j].y * rstd * gg[j].y); w.y = pk2(v[r][j].z * rstd * gg[j].z, v[r][j].w * rstd * gg[j].w); o8[64 * j] = w; } }
}
constexpr int I_IN = 16 * 88, I_KV = 16 * 32, I_OUT = 16 * 32, I_Q = 16 * 16, I_O = 8 * 32, I_UP = 16 * 128, I_DN = 64 * 32;
constexpr int ITEMS_EARLY = I_IN + I_KV, ITEMS_ALL = ITEMS_EARLY + I_OUT + I_Q + I_O + I_UP + I_DN;
__device__ __forceinline__ void transpose_items(Frame& F, int it0, int it1, int gw, int NGW) {
    LAS float* scr = (LAS float*)(F.lds + F.wave * 16384);
    bf16_t* Win_t = (bf16_t*)(F.ws + WS_WIN); bf16_t* Wout_t = (bf16_t*)(F.ws + WS_WOUT); bf16_t* Wq_t = (bf16_t*)(F.ws + WS_WQ); bf16_t* Wkv_t = (bf16_t*)(F.ws + WS_WKV);
    bf16_t* Wo_t = (bf16_t*)(F.ws + WS_WO); bf16_t* Wup_t = (bf16_t*)(F.ws + WS_WUP); bf16_t* Wdn_t = (bf16_t*)(F.ws + WS_WDN);
    for (int it = it0 + gw; it < it1; it += NGW) {
        int r = it;
        if (r < I_IN) { const int kb = r / 88, nb = r % 88; p0_transpose_item(F.w_in, D, INW, Win_t, win_dest(32 * nb), nullptr, scr, 64 * kb, 32 * nb, F.lane); continue; } r -= I_IN;
        if (r < I_KV) { const int kb = r / 32, nb = r % 32; p0_transpose_item(F.wkv, D, D, Wkv_t, 32 * nb, nullptr, scr, 64 * kb, 32 * nb, F.lane); continue; } r -= I_KV;
        if (r < I_OUT) { const int kb = r / 32, nb = r % 32; p0_transpose_item(F.w_out, D, D, Wout_t, 32 * nb, nullptr, scr, 64 * kb, 32 * nb, F.lane); continue; } r -= I_OUT;
        if (r < I_Q) { const int kb = r / 16, nb = r % 16; p0_transpose_item(F.wq, D, 512, Wq_t, 32 * nb, F.g2, scr, 64 * kb, 32 * nb, F.lane); continue; } r -= I_Q;
        if (r < I_O) { const int kb = r / 32, nb = r % 32; p0_transpose_item(F.wo, 512, D, Wo_t, 32 * nb, nullptr, scr, 64 * kb, 32 * nb, F.lane); continue; } r -= I_O;
        if (r < I_UP) { const int kb = r / 128, nb = r % 128; p0_transpose_item(F.wup, D, FF, Wup_t, 32 * nb, F.g3, scr, 64 * kb, 32 * nb, F.lane); continue; } r -= I_UP;
        { const int kb = r / 32, nb = r % 32; p0_transpose_item(F.wdn, FF, D, Wdn_t, 32 * nb, nullptr, scr, 64 * kb, 32 * nb, F.lane); }
    }
}
__device__ __forceinline__ void p0_prologue(Frame& F) {
    const int gw = F.bid * 8 + F.wave, NGW = F.G * 8;
    transpose_items(F, 0, (F.G >= 128) ? ITEMS_EARLY : ITEMS_ALL, gw, NGW);
    bf16_t* HN1 = (bf16_t*)(F.ws + WS_HN1); bf16_t* MN = (bf16_t*)(F.ws + WS_MN);
    for (int m = gw; m < M; m += 8 * NGW) rms_rows_to_bf16<8>(F.x, F.g1, HN1, m, NGW, M, F.lane);
    for (int m = gw; m < MM; m += 2 * NGW) rms_rows_to_bf16<2>(F.mem, F.gm, MN, m, NGW, MM, F.lane);
    for (int e = F.bid * 512 + F.tid; e < 2 * 65536; e += F.G * 512) ((float*)(F.ws + WS_SS2))[e] = 0.f;
    float* rope = (float*)(F.ws + WS_ROPE);
    for (int e = F.bid * 512 + F.tid; e < M * 8; e += F.G * 512) { const int row = e >> 3, j = e & 7;
        const double inv_rev = (double)exp2f(-(float)j * (0.125f * 18.931568569324174f)) * 0.15915494309189535;
        const double rev = (double)F.pos[row] * inv_rev; const float fr = (float)(rev - rint(rev));
        rope[row * 16 + j] = __builtin_amdgcn_cosf(fr); rope[row * 16 + 8 + j] = __builtin_amdgcn_sinf(fr); }
    if (F.bid == 0) { float* LB = (float*)(F.ws + WS_LB); for (int k = F.tid; k < 512; k += 512) LB[k] = 1.0f / (1.0f + expf(F.hlb[512 + k] - F.hlb[k])); }
}

__device__ __forceinline__ void hgrn_simple(Frame& F, int b, int h) {
    LAS float* qs = (LAS float*)F.lds; LAS float* ks = qs + 64 * 128; LAS float* vs = ks + 64 * 128; LAS float* op = vs + 64 * 128;
    const bf16_t* QT = (const bf16_t*)(F.ws + WS_QT); const bf16_t* KT = (const bf16_t*)(F.ws + WS_KT); const bf16_t* V = (const bf16_t*)(F.ws + WS_V); const bf16_t* SG = (const bf16_t*)(F.ws + WS_SG);
    const float* ELAST = (const float*)(F.ws + WS_ELAST); bf16_t* MIX = (bf16_t*)(F.ws + WS_MIX);
    const int v = F.tid & 127, kg = F.tid >> 7;
    float S[32];
#pragma unroll
    for (int i = 0; i < 32; ++i) S[i] = 0.f;
    for (int c = 0; c < 32; ++c) {
        const int row0 = b * SEQ + c * 64;
        __syncthreads();
        for (int e = F.tid; e < 64 * 128; e += 512) { const int t = e >> 7, k = e & 127; const size_t o = (size_t)(row0 + t) * 512 + h * 128 + k;
            qs[e] = bf2f(QT[o]); ks[e] = bf2f(KT[o]); vs[e] = bf2f(V[o]); }
        __syncthreads();
        for (int tg = 0; tg < 4; ++tg) {
            for (int tt = 0; tt < 16; ++tt) { const int t = tg * 16 + tt; const float vv = vs[t * 128 + v]; float ao = 0.f;
#pragma unroll
                for (int kk = 0; kk < 32; ++kk) { S[kk] += ks[t * 128 + 32 * kg + kk] * vv; ao += S[kk] * qs[t * 128 + 32 * kg + kk]; }
                op[(kg * 16 + tt) * 128 + v] = ao; }
            __syncthreads();
#pragma unroll
            for (int rr = 0; rr < 2; ++rr) { const int tt = F.wave * 2 + rr, row = row0 + tg * 16 + tt;
                float o0 = 0.f, o1 = 0.f;
#pragma unroll
                for (int g = 0; g < 4; ++g) { o0 += op[(g * 16 + tt) * 128 + F.lane]; o1 += op[(g * 16 + tt) * 128 + F.lane + 64]; }
                const float rstd = 1.0f / sqrtf(wave_sum(o0 * o0 + o1 * o1) * (1.0f / 128.0f) + EPS);
                const size_t so = (size_t)row * 512 + h * 128;
                MIX[(size_t)row * 1024 + h * 128 + F.lane] = (bf16_t)f2bf(o0 * rstd * F.hng[F.lane] * bf2f(SG[so + F.lane]));
                MIX[(size_t)row * 1024 + h * 128 + F.lane + 64] = (bf16_t)f2bf(o1 * rstd * F.hng[F.lane + 64] * bf2f(SG[so + F.lane + 64])); }
            __syncthreads();
        }
        const float* el = ELAST + (size_t)(row0 >> 6) * 512 + h * 128 + 32 * kg;
#pragma unroll
        for (int kk = 0; kk < 32; ++kk) S[kk] *= el[kk];
    }
}
__device__ __forceinline__ void swa_simple(Frame& F, int row, int hq) {
    const bf16_t* SQ = (const bf16_t*)(F.ws + WS_SQ); const bf16_t* SK = (const bf16_t*)(F.ws + WS_SK); const bf16_t* SV = (const bf16_t*)(F.ws + WS_SV); bf16_t* MIX = (bf16_t*)(F.ws + WS_MIX);
    const int t = row & (SEQ - 1), kvh = hq >> 2, lane = F.lane;
    const float q = bf2f(SQ[(size_t)row * 512 + hq * 64 + lane]);
    const int nk = (t + 1 < 128) ? t + 1 : 128; const int r0 = row - nk + 1;
    float s0 = -INFINITY, s1 = -INFINITY;
    for (int j = 0; j < nk; ++j) { const float d = wave_sum(q * bf2f(SK[(size_t)(r0 + j) * 128 + kvh * 64 + lane]));
        if (lane == (j & 63)) { if (j < 64) s0 = d; else s1 = d; } }
    const float sink = F.sinks[hq] * 1.4426950408889634f;
    const float mx = fmaxf(wave_max(fmaxf(s0, s1)), sink);
    const float p0 = exp2f(s0 - mx), p1 = exp2f(s1 - mx);
    const float den = wave_sum(p0 + p1) + exp2f(sink - mx);
    float o = 0.f;
    for (int j = 0; j < nk; ++j) { const float p = __shfl(j < 64 ? p0 : p1, j & 63); o += p * bf2f(SV[(size_t)(r0 + j) * 128 + kvh * 64 + lane]); }
    MIX[(size_t)row * 1024 + 512 + hq * 64 + lane] = (bf16_t)f2bf(o / den);
}
__device__ __forceinline__ void kn_item(Frame& F, int item) {
    const bf16_t* KVM = (const bf16_t*)(F.ws + WS_KVM); bf16_t* KN = (bf16_t*)(F.ws + WS_KN);
    const int r = item >> 2, h = item & 3, lane = F.lane;
    const unsigned w = *(const unsigned*)(KVM + (size_t)r * 1024 + h * 128 + 2 * lane);
    const float a = bflo(w), b = bfhi(w);
    const float rstd = 1.0f / sqrtf(wave_sum(a * a + b * b) * (1.0f / 128.0f) + EPS);
    *(unsigned*)(KN + (size_t)r * 512 + h * 128 + 2 * lane) = pk2(a * rstd * F.xkg[2 * lane], b * rstd * F.xkg[2 * lane + 1]);
}
__device__ __forceinline__ void kn_items(Frame& F, int it0, int stride) {
    const bf16_t* KVM = (const bf16_t*)(F.ws + WS_KVM); bf16_t* KN = (bf16_t*)(F.ws + WS_KN);
    const int lane = F.lane; const float g0 = F.xkg[2 * lane], g1 = F.xkg[2 * lane + 1];
    for (int it = it0; it < MM * 4; it += 4 * stride) {
        unsigned w[4];
#pragma unroll
        for (int j = 0; j < 4; ++j) { const int item = it + j * stride; w[j] = (item < MM * 4) ? *(const unsigned*)(KVM + (size_t)(item >> 2) * 1024 + (item & 3) * 128 + 2 * lane) : 0u; }
        __builtin_amdgcn_sched_barrier(0);
#pragma unroll
        for (int j = 0; j < 4; ++j) { const int item = it + j * stride; const float a = bflo(w[j]), b = bfhi(w[j]);
            const float rstd = 1.0f / sqrtf(wave_sum(a * a + b * b) * (1.0f / 128.0f) + EPS);
            if (item < MM * 4) *(unsigned*)(KN + (size_t)(item >> 2) * 512 + (item & 3) * 128 + 2 * lane) = pk2(a * rstd * g0, b * rstd * g1); }
    }
}
__device__ __forceinline__ void xattn_simple(Frame& F, int row, int h) {
    const bf16_t* QX = (const bf16_t*)(F.ws + WS_QX); const bf16_t* KN = (const bf16_t*)(F.ws + WS_KN); const bf16_t* KVM = (const bf16_t*)(F.ws + WS_KVM); bf16_t* XO = (bf16_t*)(F.ws + WS_XO);
    const int b = row >> 11, lane = F.lane;
    const unsigned qw = *(const unsigned*)(QX + (size_t)row * 512 + h * 128 + 2 * lane);
    float q0 = bflo(qw), q1 = bfhi(qw);
    const float rstd = 1.0f / sqrtf(wave_sum(q0 * q0 + q1 * q1) * (1.0f / 128.0f) + EPS) * 0.08838834764831845f;
    q0 *= rstd * F.xqg[2 * lane]; q1 *= rstd * F.xqg[2 * lane + 1];
    float s[4] = {0.f, 0.f, 0.f, 0.f};
    for (int mm = 0; mm < 256; ++mm) { const unsigned kw = *(const unsigned*)(KN + (size_t)(b * 256 + mm) * 512 + h * 128 + 2 * lane);
        const float d = wave_sum(q0 * bflo(kw) + q1 * bfhi(kw));
        if (lane == (mm & 63)) {
#pragma unroll
            for (int g = 0; g < 4; ++g) if (g == (mm >> 6)) s[g] = d; } }
    const float mx = wave_max(fmaxf(fmaxf(s[0], s[1]), fmaxf(s[2], s[3])));
    float p[4]; float ps = 0.f;
#pragma unroll
    for (int g = 0; g < 4; ++g) { p[g] = __expf(s[g] - mx); ps += p[g]; }
    const float den = wave_sum(ps);
    float o0 = 0.f, o1 = 0.f;
#pragma unroll
    for (int g = 0; g < 4; ++g)
        for (int j = 0; j < 64; ++j) { const float pj = __shfl(p[g], j); const unsigned vw = *(const unsigned*)(KVM + (size_t)(b * 256 + g * 64 + j) * 1024 + 512 + h * 128 + 2 * lane);
            o0 += pj * bflo(vw); o1 += pj * bfhi(vw); }
    *(unsigned*)(XO + (size_t)row * 512 + h * 128 + 2 * lane) = pk2(o0 / den, o1 / den);
}


typedef float f32x16 __attribute__((ext_vector_type(16)));
typedef short s16x4 __attribute__((ext_vector_type(4)));
typedef short v4i16_t __attribute__((ext_vector_type(4)));
typedef float f32x2_t __attribute__((ext_vector_type(2)));
typedef __bf16 bf16x2_t __attribute__((ext_vector_type(2)));
#define MFMA32(a, b, c) __builtin_amdgcn_mfma_f32_32x32x16_bf16((a), (b), (c), 0, 0, 0)
__device__ __forceinline__ unsigned cvtpk(float lo, float hi) { f32x2_t v = {lo, hi}; bf16x2_t b = __builtin_convertvector(v, bf16x2_t); return __builtin_bit_cast(unsigned, b); }
__device__ __forceinline__ s16x4 ds_tr(const LAS unsigned char* p) { return __builtin_bit_cast(s16x4, __builtin_amdgcn_ds_read_tr16_b64_v4i16((LAS v4i16_t*)p)); }
__device__ __forceinline__ bf16x8 cat8(s16x4 lo, s16x4 hi) { return (bf16x8){lo[0], lo[1], lo[2], lo[3], hi[0], hi[1], hi[2], hi[3]}; }
__device__ __forceinline__ bf16x8 pack_step(const f32x16& x, int s) {
    u32x4 p; p.x = cvtpk(x[8 * s], x[8 * s + 1]); p.y = cvtpk(x[8 * s + 2], x[8 * s + 3]); p.z = cvtpk(x[8 * s + 4], x[8 * s + 5]); p.w = cvtpk(x[8 * s + 6], x[8 * s + 7]);
    return __builtin_bit_cast(bf16x8, p);
}
template <int RB> __device__ __forceinline__ unsigned offa(unsigned row, unsigned ch) { return RB * (row >> 3) + 512u * (ch >> 2) + 64u * (row & 7) + 16u * ((ch & 3) ^ ((row >> 2) & 3)); }

__device__ __forceinline__ void xattn_pair(Frame& F, int pair) {
    const bf16_t* QX = (const bf16_t*)(F.ws + WS_QX); const bf16_t* KN = (const bf16_t*)(F.ws + WS_KN); const bf16_t* KVM = (const bf16_t*)(F.ws + WS_KVM); bf16_t* XO = (bf16_t*)(F.ws + WS_XO);
    int lane = F.lane; asm volatile("" : "+v"(lane));
    const int bh = pair >> 2, b = bh >> 2, h = bh & 3, r32 = lane & 31, hi = lane >> 5;
    LAS unsigned char* Kimg = F.lds; LAS unsigned char* Vimg = F.lds + 65536; LAS unsigned char* stg = F.lds + 131072 + F.wave * 2560;
    __syncthreads();
    {
        u32x4 kt_[8], vt_[8];
#pragma unroll
        for (int it = 0; it < 8; ++it) { const int i = F.wave * 64 + lane + 512 * it, key = i >> 4, ch = i & 15;
            kt_[it] = *(const u32x4*)(KN + (size_t)(b * 256 + key) * 512 + h * 128 + 8 * ch);
            vt_[it] = *(const u32x4*)(KVM + (size_t)(b * 256 + key) * 1024 + 512 + h * 128 + 8 * ch); }
#pragma unroll
        for (int it = 0; it < 8; ++it) { const int i = F.wave * 64 + lane + 512 * it, key = i >> 4, ch = i & 15;
            *(LAS u32x4*)(Kimg + offa<2048>(key, ch)) = kt_[it]; *(LAS u32x4*)(Vimg + offa<2048>(key, ch)) = vt_[it]; }
    }
    __syncthreads();
    const float gqm = wave_max(fmaxf(fabsf(F.xqg[lane]), fabsf(F.xqg[lane + 64]))), gkm = wave_max(fmaxf(fabsf(F.xkg[lane]), fabsf(F.xkg[lane + 64])));
    const float C2 = 11.313708498984761f * gqm * gkm * 1.4426950408889634f;
    const unsigned kb = 2048u * (r32 >> 3) + 64u * (r32 & 7), xk = (r32 >> 2) & 3;
    const unsigned kbe = kb + 16u * ((unsigned)hi ^ xk), kbo = kb + 16u * ((2u + hi) ^ xk);
    const unsigned q4 = (lane & 15) >> 2, p4 = lane & 3, blk = (lane >> 4) & 1;
    const unsigned vb = 64u * (4 * hi + q4) + 8u * (p4 & 1), vc = 2 * blk + (p4 >> 1);
    const unsigned vb0 = vb + 16u * (vc ^ (unsigned)hi), vb1 = vb + 2048u + 16u * (vc ^ (2u + hi));
    for (int qq = 0; qq < 2; ++qq) {
        const int R0 = b * SEQ + ((pair & 3) * 2 + qq) * 256 + F.wave * 32;
        const bf16_t* qp = QX + (size_t)(R0 + r32) * 512 + h * 128 + 8 * hi;
        u32x4 qraw[8]; float ss = 0.f;
#pragma unroll
        for (int ks = 0; ks < 8; ++ks) { qraw[ks] = *(const u32x4*)(qp + 16 * ks);
#pragma unroll
            for (int j = 0; j < 4; ++j) { const float a = bflo(qraw[ks][j]), c = bfhi(qraw[ks][j]); ss += a * a + c * c; } }
        ss += __shfl_xor(ss, 32);
        const float sc = frsq(ss * (1.0f / 128.0f) + EPS) * (0.08838834764831845f * 1.4426950408889634f);
        bf16x8 qf[8];
#pragma unroll
        for (int ks = 0; ks < 8; ++ks) { const f32x4 g0 = *(const f32x4*)(F.xqg + 16 * ks + 8 * hi), g1 = *(const f32x4*)(F.xqg + 16 * ks + 8 * hi + 4);
            u32x4 w; w.x = cvtpk(bflo(qraw[ks].x) * sc * g0[0], bfhi(qraw[ks].x) * sc * g0[1]); w.y = cvtpk(bflo(qraw[ks].y) * sc * g0[2], bfhi(qraw[ks].y) * sc * g0[3]);
            w.z = cvtpk(bflo(qraw[ks].z) * sc * g1[0], bfhi(qraw[ks].z) * sc * g1[1]); w.w = cvtpk(bflo(qraw[ks].w) * sc * g1[2], bfhi(qraw[ks].w) * sc * g1[3]);
            qf[ks] = __builtin_bit_cast(bf16x8, w); }
        f32x16 o[4]; float lsum = 0.f;
#pragma unroll
        for (int c = 0; c < 4; ++c)
#pragma unroll
            for (int r = 0; r < 16; ++r) o[c][r] = 0.f;
        bf16x8 kf[8];
#pragma unroll
        for (int ks = 0; ks < 8; ++ks) kf[ks] = *(const LAS bf16x8*)(Kimg + ((ks & 1) ? kbo : kbe) + 512 * (ks >> 1));
        for (int kt = 0; kt < 8; ++kt) {
            const LAS unsigned char* Kn = Kimg + ((kt < 7) ? kt + 1 : kt) * 8192; const LAS unsigned char* Vt = Vimg + kt * 8192;
            f32x16 acc;
#pragma unroll
            for (int r = 0; r < 16; ++r) acc[r] = -C2;
#pragma unroll
            for (int ks = 0; ks < 8; ++ks) acc = MFMA32(kf[ks], qf[ks], acc);
            __builtin_amdgcn_sched_barrier(0);
            bf16x8 vf[2][4];
#pragma unroll
            for (int s = 0; s < 2; ++s)
#pragma unroll
                for (int c = 0; c < 4; ++c) vf[s][c] = cat8(ds_tr(Vt + s * 4096 + c * 512 + vb0), ds_tr(Vt + s * 4096 + c * 512 + vb1));
#pragma unroll
            for (int ks = 0; ks < 8; ++ks) kf[ks] = *(const LAS bf16x8*)(Kn + ((ks & 1) ? kbo : kbe) + 512 * (ks >> 1));
            __builtin_amdgcn_sched_barrier(0);
#pragma unroll
            for (int r = 0; r < 16; ++r) { acc[r] = __builtin_amdgcn_exp2f(acc[r]); lsum += acc[r]; }
            const bf16x8 pa0 = pack_step(acc, 0), pa1 = pack_step(acc, 1);
#pragma unroll
            for (int s = 0; s < 2; ++s)
#pragma unroll
                for (int c = 0; c < 4; ++c) o[c] = MFMA32(vf[s][c], s ? pa1 : pa0, o[c]);
        }
        lsum += __shfl_xor(lsum, 32);
        const float inv = frcp(lsum);
#pragma unroll
        for (int c = 0; c < 4; ++c) {
#pragma unroll
            for (int g = 0; g < 4; ++g) { u32x2 w; w.x = cvtpk(o[c][4 * g] * inv, o[c][4 * g + 1] * inv); w.y = cvtpk(o[c][4 * g + 2] * inv, o[c][4 * g + 3] * inv);
                *(LAS u32x2*)(stg + r32 * 80 + (8 * g + 4 * hi) * 2) = w; }
#pragma unroll
            for (int j = 0; j < 2; ++j) { const int idx = lane + 64 * j, row = idx >> 2, c8 = idx & 3;
                const u32x4 v = *(const LAS u32x4*)(stg + row * 80 + 16 * c8);
                *(u32x4*)(XO + (size_t)(R0 + row) * 512 + h * 128 + 32 * c + 8 * c8) = v; }
        }
    }
}

__device__ __forceinline__ void swa_unit(Frame& F, int u) {
    const bf16_t* SQ = (const bf16_t*)(F.ws + WS_SQ); const bf16_t* SK = (const bf16_t*)(F.ws + WS_SK); const bf16_t* SV = (const bf16_t*)(F.ws + WS_SV); bf16_t* MIX = (bf16_t*)(F.ws + WS_MIX);
    int lane = F.lane; asm volatile("" : "+v"(lane));
    const int b = u >> 5, n = (u >> 1) & 15, kvh = u & 1, r32 = lane & 31, hi = lane >> 5;
    LAS unsigned char* Kimg = F.lds; LAS unsigned char* Vimg = F.lds + 32768; LAS unsigned char* stg = F.lds + 65536 + F.wave * 4608;
    __syncthreads();
    {
        u32x4 kt_[4], vt_[4];
#pragma unroll
        for (int it = 0; it < 4; ++it) { const int i = F.wave * 64 + lane + 512 * it, key = i >> 3, ch = i & 7;
            const int keyl = (n > 0 || key >= 128) ? key : key + 128; const size_t row = (size_t)b * SEQ + (n - 1) * 128 + keyl;
            kt_[it] = *(const u32x4*)(SK + row * 128 + kvh * 64 + 8 * ch); vt_[it] = *(const u32x4*)(SV + row * 128 + kvh * 64 + 8 * ch); }
#pragma unroll
        for (int it = 0; it < 4; ++it) { const int i = F.wave * 64 + lane + 512 * it, key = i >> 3, ch = i & 7;
            *(LAS u32x4*)(Kimg + offa<1024>(key, ch)) = kt_[it]; *(LAS u32x4*)(Vimg + offa<1024>(key, ch)) = vt_[it]; }
    }
    __syncthreads();
    const int hq = kvh * 4 + (F.wave >> 1);
    const float gqm = wave_max(fabsf(F.qng[lane])), gkm = wave_max(fabsf(F.kng[lane]));
    const float sinkv = F.sinks[hq];
    const float C2 = fmaxf(8.0f * gqm * gkm, sinkv) * 1.4426950408889634f;
    const unsigned kb = 1024u * (r32 >> 3) + 64u * (r32 & 7), xk = (r32 >> 2) & 3;
    const unsigned kbe = kb + 16u * ((unsigned)hi ^ xk), kbo = kb + 16u * ((2u + hi) ^ xk);
    const unsigned q4 = (lane & 15) >> 2, p4 = lane & 3, blk = (lane >> 4) & 1;
    const unsigned vb = 64u * (4 * hi + q4) + 8u * (p4 & 1), vc = 2 * blk + (p4 >> 1);
    const unsigned vb0 = vb + 16u * (vc ^ (unsigned)hi), vb1 = vb + 1024u + 16u * (vc ^ (2u + hi));
    for (int aa = 0; aa < 2; ++aa) {
        const int a = (F.wave & 1) * 2 + aa;
        const int R0 = b * SEQ + n * 128 + 32 * a;
        const bf16_t* qp = SQ + (size_t)(R0 + r32) * 512 + hq * 64 + 8 * hi;
        bf16x8 qf[4];
#pragma unroll
        for (int ks = 0; ks < 4; ++ks) qf[ks] = *(const bf16x8*)(qp + 16 * ks);
        f32x16 o[2]; float lsum = 0.f;
#pragma unroll
        for (int c = 0; c < 2; ++c)
#pragma unroll
            for (int r = 0; r < 16; ++r) o[c][r] = 0.f;
        for (int j = 0; j < 5; ++j) {
            const int kt = a + j;
            if (n == 0 && kt < 4) continue;
            const LAS unsigned char* Kt = Kimg + kt * 4096; const LAS unsigned char* Vt = Vimg + kt * 4096;
            f32x16 acc;
#pragma unroll
            for (int r = 0; r < 16; ++r) acc[r] = -C2;
#pragma unroll
            for (int ks = 0; ks < 4; ++ks) { const bf16x8 kf = *(const LAS bf16x8*)(Kt + ((ks & 1) ? kbo : kbe) + 512 * (ks >> 1)); acc = MFMA32(kf, qf[ks], acc); }
#pragma unroll
            for (int r = 0; r < 16; ++r) { const int kl = (r & 3) + 8 * (r >> 2) + 4 * hi;
                const bool valid = (j == 0) ? (r32 < kl) : ((j == 4) ? (kl <= r32) : true);
                const float p = valid ? __builtin_amdgcn_exp2f(acc[r]) : 0.f; acc[r] = p; lsum += p; }
            const bf16x8 pa0 = pack_step(acc, 0), pa1 = pack_step(acc, 1);
#pragma unroll
            for (int s = 0; s < 2; ++s)
#pragma unroll
                for (int c = 0; c < 2; ++c) { const bf16x8 vf = cat8(ds_tr(Vt + s * 2048 + c * 512 + vb0), ds_tr(Vt + s * 2048 + c * 512 + vb1)); o[c] = MFMA32(vf, s ? pa1 : pa0, o[c]); }
        }
        lsum += __shfl_xor(lsum, 32);
        const float inv = frcp(lsum + __builtin_amdgcn_exp2f(sinkv * 1.4426950408889634f - C2));
#pragma unroll
        for (int c = 0; c < 2; ++c)
#pragma unroll
            for (int g = 0; g < 4; ++g) { u32x2 w; w.x = cvtpk(o[c][4 * g] * inv, o[c][4 * g + 1] * inv); w.y = cvtpk(o[c][4 * g + 2] * inv, o[c][4 * g + 3] * inv);
                *(LAS u32x2*)(stg + r32 * 144 + (32 * c + 8 * g + 4 * hi) * 2) = w; }
#pragma unroll
        for (int jj = 0; jj < 4; ++jj) { const int idx = lane + 64 * jj, row = idx >> 3, c8 = idx & 7;
            const u32x4 v = *(const LAS u32x4*)(stg + row * 144 + 16 * c8);
            *(u32x4*)(MIX + (size_t)(R0 + row) * 1024 + 512 + hq * 64 + 8 * c8) = v; }
    }
}


#define HG_BAR() asm volatile("s_waitcnt lgkmcnt(0)\n\ts_barrier" ::: "memory")
__device__ __forceinline__ void hgrn_mfma(Frame& F, int b, int h) {
    const bf16_t* QT = (const bf16_t*)(F.ws + WS_QT); const bf16_t* KT = (const bf16_t*)(F.ws + WS_KT); const bf16_t* V = (const bf16_t*)(F.ws + WS_V); const bf16_t* SG = (const bf16_t*)(F.ws + WS_SG);
    const float* ELAST = (const float*)(F.ws + WS_ELAST); bf16_t* MIX = (bf16_t*)(F.ws + WS_MIX);
    int lane = F.lane; asm volatile("" : "+v"(lane));
    const int r32 = lane & 31, hi = lane >> 5, w = F.wave, tid = w * 64 + lane;
    LAS unsigned char* img = F.lds;
    LAS unsigned char* pfrag = F.lds + 98304;
    LAS float* rowsq = (LAS float*)(F.lds + 104448);
    LAS float* elds = (LAS float*)(F.lds + 106496);
    LAS float* ngl = (LAS float*)(F.lds + 107520);
    LAS unsigned char* stg = F.lds + 108032 + (w & 3) * 5120;
    const size_t rbase = (size_t)b * SEQ; const int colh = h * 128;
    const unsigned q4 = (lane & 15) >> 2, p4 = lane & 3, blk = (lane >> 4) & 1, vc = 2 * blk + (p4 >> 1), p8 = 8u * (p4 & 1);
    const unsigned n0 = 2048u * hi + 64u * q4 + 16u * (vc ^ ((2u * hi) & 3u)) + p8, n1 = 2048u * hi + 64u * (4 + q4) + 16u * (vc ^ ((2u * hi + 1u) & 3u)) + p8;
    const unsigned k0 = 64u * (4 * hi + q4) + 16u * (vc ^ (unsigned)hi) + p8, k1 = 2048u + 64u * (4 * hi + q4) + 16u * (vc ^ (2u + hi)) + p8;
    const unsigned rb = 2048u * (r32 >> 3) + 64u * (r32 & 7), xr = (r32 >> 2) & 3;
    const unsigned rbe = rb + 16u * ((unsigned)hi ^ xr), rbo = rb + 16u * ((2u + hi) ^ xr);
    const unsigned qk00 = rb + 8u * hi + 16u * (0u ^ xr), qk01 = rb + 8u * hi + 16u * (1u ^ xr), qk10 = rb + 8u * hi + 16u * (2u ^ xr), qk11 = rb + 8u * hi + 16u * (3u ^ xr);
    __syncthreads();
#pragma unroll
    for (int i = 0; i < 6; ++i) { const int tensor = i >> 1, rem = tid + 512 * (i & 1), r = rem >> 4, ch = rem & 15;
        const bf16_t* src = (tensor == 0 ? QT : tensor == 1 ? KT : V) + (rbase + r) * 512 + colh + 8 * ch;
        *(LAS u32x4*)(img + tensor * 16384 + offa<2048>(r, ch)) = *(const u32x4*)src; }
    if (tid < 32) *(LAS f32x4*)(elds + 4 * tid) = *(const f32x4*)(ELAST + (rbase >> 6) * 512 + colh + 4 * tid);
    if (tid >= 64 && tid < 96) *(LAS f32x4*)(ngl + 4 * (tid - 64)) = *(const f32x4*)(F.hng + 4 * (tid - 64));
    __syncthreads();
    if (w < 4) {
        const int vb = w;
        f32x16 S[4];
#pragma unroll
        for (int kb = 0; kb < 4; ++kb)
#pragma unroll
            for (int r = 0; r < 16; ++r) S[kb][r] = 0.f;
        for (int c = 0; c < 32; ++c) {
            const LAS unsigned char* Qi = img + (c & 1) * 49152; const LAS unsigned char* Ki = Qi + 16384; const LAS unsigned char* Vi = Qi + 32768;
            const size_t row0 = rbase + 64 * c;
            f32x16 o[2];
#pragma unroll
            for (int tb = 0; tb < 2; ++tb)
#pragma unroll
                for (int r = 0; r < 16; ++r) o[tb][r] = 0.f;
#pragma unroll
            for (int kh = 0; kh < 2; ++kh) {
                u32x2 ql[2][2][2][2];
#pragma unroll
                for (int kl = 0; kl < 2; ++kl)
#pragma unroll
                    for (int s = 0; s < 2; ++s)
#pragma unroll
                        for (int tb = 0; tb < 2; ++tb) { const LAS unsigned char* qp = Qi + 8192 * tb + 512 * (2 * kh + kl);
                            ql[kl][s][tb][0] = *(const LAS u32x2*)(qp + (s ? qk10 : qk00)); ql[kl][s][tb][1] = *(const LAS u32x2*)(qp + (s ? qk11 : qk01)); }
                __builtin_amdgcn_sched_barrier(0);
#pragma unroll
                for (int kl = 0; kl < 2; ++kl)
#pragma unroll
                    for (int s = 0; s < 2; ++s) { const bf16x8 pa = pack_step(S[2 * kh + kl], s);
#pragma unroll
                        for (int tb = 0; tb < 2; ++tb) { const u32x4 qq = {ql[kl][s][tb][0].x, ql[kl][s][tb][0].y, ql[kl][s][tb][1].x, ql[kl][s][tb][1].y};
                            o[tb] = MFMA32(pa, __builtin_bit_cast(bf16x8, qq), o[tb]); } }
                __builtin_amdgcn_sched_barrier(0);
            }
            __builtin_amdgcn_sched_barrier(0);
#pragma unroll
            for (int ks = 0; ks < 4; ++ks) {
                const LAS unsigned char* vp = Vi + 4096 * ks + 512 * vb; const bf16x8 bfr = cat8(ds_tr(vp + n0), ds_tr(vp + n1)); bf16x8 af[4];
#pragma unroll
                for (int kb = 0; kb < 4; ++kb) { const LAS unsigned char* kp = Ki + 4096 * ks + 512 * kb; af[kb] = cat8(ds_tr(kp + n0), ds_tr(kp + n1)); }
                __builtin_amdgcn_sched_barrier(0);
#pragma unroll
                for (int kb = 0; kb < 4; ++kb) S[kb] = MFMA32(af[kb], bfr, S[kb]);
            }
            { const LAS float* ep = elds + (c & 1) * 128;
#pragma unroll
                for (int kb = 0; kb < 4; ++kb) { f32x4 e4[4];
#pragma unroll
                    for (int g = 0; g < 4; ++g) e4[g] = *(const LAS f32x4*)(ep + 32 * kb + 8 * g + 4 * hi);
#pragma unroll
                    for (int g = 0; g < 4; ++g)
#pragma unroll
                        for (int i = 0; i < 4; ++i) S[kb][4 * g + i] *= e4[g][i]; } }
            HG_BAR();
            {
                bf16x8 vf[2][2], pf[3][2];
#pragma unroll
                for (int sb = 0; sb < 2; ++sb)
#pragma unroll
                    for (int st = 0; st < 2; ++st) { const LAS unsigned char* vp = Vi + 8192 * sb + 4096 * st + 512 * vb; vf[sb][st] = cat8(ds_tr(vp + k0), ds_tr(vp + k1)); }
#pragma unroll
                for (int tl = 0; tl < 3; ++tl)
#pragma unroll
                    for (int st = 0; st < 2; ++st) pf[tl][st] = *(const LAS bf16x8*)(pfrag + (tl * 2 + st) * 1024 + lane * 16);
                __builtin_amdgcn_sched_barrier(0);
#pragma unroll
                for (int st = 0; st < 2; ++st) { o[0] = MFMA32(vf[0][st], pf[0][st], o[0]); o[1] = MFMA32(vf[0][st], pf[1][st], o[1]); o[1] = MFMA32(vf[1][st], pf[2][st], o[1]); }
            }
            f32x4 ng[4];
#pragma unroll
            for (int g = 0; g < 4; ++g) ng[g] = *(const LAS f32x4*)(ngl + 32 * vb + 8 * g + 4 * hi);
#pragma unroll
            for (int tb = 0; tb < 2; ++tb) { float ss = 0.f;
#pragma unroll
                for (int r = 0; r < 16; ++r) ss += o[tb][r] * o[tb][r];
                ss += __shfl_xor(ss, 32);
                if (hi == 0) rowsq[(c & 1) * 256 + vb * 64 + 32 * tb + r32] = ss;
#pragma unroll
                for (int g = 0; g < 4; ++g) { u32x2 v; v.x = cvtpk(o[tb][4 * g] * ng[g][0], o[tb][4 * g + 1] * ng[g][1]); v.y = cvtpk(o[tb][4 * g + 2] * ng[g][2], o[tb][4 * g + 3] * ng[g][3]);
                    *(LAS u32x2*)(stg + (c & 1) * 20480 + tb * 2560 + r32 * 80 + (8 * g + 4 * hi) * 2) = v; } }
            HG_BAR();
        }
    } else {
        const int ht = tid - 256, tile = w - 4, sb = (tile == 2) ? 1 : 0, tb = (tile == 0) ? 0 : 1;
        u32x4 sgp[2][2];
        auto hgrn_sgload = [&](int cc, int tb2) __attribute__((always_inline)) {
            const bf16_t* sgb = SG + (rbase + 64 * cc) * 512 + colh + 32 * (w - 4);
#pragma unroll
            for (int j = 0; j < 2; ++j) { const int idx = lane + 64 * j, row = idx >> 2, c8 = idx & 3, t = 32 * tb2 + row; sgp[tb2][j] = *(const u32x4*)(sgb + (unsigned)(t * 512 + 8 * c8)); }
        };
        auto hgrn_finalize = [&](int cc, int tb2) __attribute__((always_inline)) {
            const int vb = w - 4; const size_t row0 = rbase + 64 * cc;
            bf16_t* mxb = MIX + row0 * 1024 + colh + 32 * vb;
            const LAS float* rq = rowsq + (cc & 1) * 256; const LAS unsigned char* sb_ = stg + (cc & 1) * 20480 + tb2 * 2560;
#pragma unroll
            for (int j = 0; j < 2; ++j) { const int idx = lane + 64 * j, row = idx >> 2, c8 = idx & 3, t = 32 * tb2 + row;
                const u32x4 sg = sgp[tb2][j];
                const float rstd = frsq(((rq[t] + rq[64 + t]) + (rq[128 + t] + rq[192 + t])) * (1.0f / 128.0f) + EPS);
                const u32x4 a = *(const LAS u32x4*)(sb_ + row * 80 + c8 * 16);
                u32x4 ov; ov.x = cvtpk(bflo(a.x) * rstd * bflo(sg.x), bfhi(a.x) * rstd * bfhi(sg.x)); ov.y = cvtpk(bflo(a.y) * rstd * bflo(sg.y), bfhi(a.y) * rstd * bfhi(sg.y));
                ov.z = cvtpk(bflo(a.z) * rstd * bflo(sg.z), bfhi(a.z) * rstd * bfhi(sg.z)); ov.w = cvtpk(bflo(a.w) * rstd * bflo(sg.w), bfhi(a.w) * rstd * bfhi(sg.w));
                *(u32x4*)(mxb + (unsigned)(t * 1024 + 8 * c8)) = ov; }
        };
        for (int c = 0; c < 32; ++c) {
            const LAS unsigned char* Qi = img + (c & 1) * 49152; const LAS unsigned char* Ki = Qi + 16384;
            u32x4 tmp[12]; f32x4 etmp = {0.f, 0.f, 0.f, 0.f};
            const size_t nrow0 = rbase + 64 * ((c + 1 < 32) ? c + 1 : c);
            const unsigned ploff = (unsigned)(ht >> 4) * 512u + 8u * (unsigned)(ht & 15);
#pragma unroll
            for (int i = 0; i < 12; ++i) { const int tensor = i >> 2;
                const bf16_t* tb_ = (tensor == 0 ? QT : tensor == 1 ? KT : V) + nrow0 * 512 + colh + (i & 3) * 8192;
                tmp[i] = *(const u32x4*)(tb_ + ploff); }
            if (ht < 32) etmp = *(const f32x4*)(ELAST + (nrow0 >> 6) * 512 + colh + (unsigned)(4 * ht));
            if (c > 0) hgrn_finalize(c - 1, 0);
            hgrn_sgload(c, 0);
            if (w < 7) {
                f32x16 acc;
#pragma unroll
                for (int r = 0; r < 16; ++r) acc[r] = 0.f;
#pragma unroll
                for (int kh = 0; kh < 2; ++kh) {
                    bf16x8 kfr[4], qfr[4];
#pragma unroll
                    for (int kq = 0; kq < 4; ++kq) { const int ks = 4 * kh + kq; const unsigned o_ = ((ks & 1) ? rbo : rbe) + 512 * (ks >> 1); kfr[kq] = *(const LAS bf16x8*)(Ki + 8192 * sb + o_); qfr[kq] = *(const LAS bf16x8*)(Qi + 8192 * tb + o_); }
                    __builtin_amdgcn_sched_barrier(0);
#pragma unroll
                    for (int kq = 0; kq < 4; ++kq) acc = MFMA32(kfr[kq], qfr[kq], acc);
                    __builtin_amdgcn_sched_barrier(0);
                }
                if (sb == tb) {
#pragma unroll
                    for (int r = 0; r < 16; ++r) { const int sl = (r & 3) + 8 * (r >> 2) + 4 * hi; if (sl > r32) acc[r] = 0.f; } }
                *(LAS bf16x8*)(pfrag + (tile * 2 + 0) * 1024 + lane * 16) = pack_step(acc, 0);
                *(LAS bf16x8*)(pfrag + (tile * 2 + 1) * 1024 + lane * 16) = pack_step(acc, 1);
            }
            HG_BAR();
            if (c + 1 < 32) {
                LAS unsigned char* dst = img + ((c + 1) & 1) * 49152;
#pragma unroll
                for (int i = 0; i < 12; ++i) { const int tensor = i >> 2, rem = ht + 256 * (i & 3), r = rem >> 4, ch = rem & 15;
                    *(LAS u32x4*)(dst + tensor * 16384 + offa<2048>(r, ch)) = tmp[i]; }
                if (ht < 32) *(LAS f32x4*)(elds + ((c + 1) & 1) * 128 + 4 * ht) = etmp;
            }
            if (c > 0) hgrn_finalize(c - 1, 1);
            hgrn_sgload(c, 1);
            HG_BAR();
        }
        hgrn_finalize(31, 0); hgrn_finalize(31, 1);
    }
}

constexpr int NPHASE = 9;
__global__ void __launch_bounds__(512, 2) layer_fwd(Args args) {
    extern __shared__ __attribute__((aligned(16))) unsigned char lds_raw[];
    Frame F;
    F.lds = (LAS unsigned char*)lds_raw; F.tid = threadIdx.x; F.lane = F.tid & 63; F.wave = __builtin_amdgcn_readfirstlane(F.tid >> 6); F.G = gridDim.x; F.bid = blockIdx.x;
    F.x = (const float*)args.in[0]; F.mem = (const float*)args.in[1]; F.pos = (const int*)args.in[2]; F.g1 = (const float*)args.in[3]; F.w_in = (const float*)args.in[4];
    F.hlb = (const float*)args.in[5]; F.hng = (const float*)args.in[6]; F.qng = (const float*)args.in[7]; F.kng = (const float*)args.in[8]; F.sinks = (const float*)args.in[9];
    F.w_out = (const float*)args.in[10]; F.g2 = (const float*)args.in[11]; F.gm = (const float*)args.in[12]; F.wq = (const float*)args.in[13]; F.wkv = (const float*)args.in[14];
    F.xqg = (const float*)args.in[15]; F.xkg = (const float*)args.in[16]; F.wo = (const float*)args.in[17]; F.g3 = (const float*)args.in[18]; F.wup = (const float*)args.in[19]; F.wdn = (const float*)args.in[20];
    F.out = args.out; F.ws = args.ws;
    unsigned char* ws = args.ws;
    const int lo = args.ph_lo, hi = args.ph_hi;
#ifndef PH_MASK
#define PH_MASK 0x1ff
#endif
#define IN(k) (((PH_MASK >> (k)) & 1) && lo <= (k) && (k) < hi)
#ifndef GSYNC_SEAM
#define GSYNC_SEAM 0
#endif
    if (F.tid < 64) ((LAS unsigned*)(F.lds + LDSCTL_OFF))[F.tid] = 0u;
    __syncthreads();
#if MK_N_LAUNCHES == 1
    static_assert(GSYNC_SEAM == 0, "the in-kernel reset of the barrier words relies on seam 0 being the cooperative-groups grid.sync()");
    if (F.bid == 0) { unsigned* bz = (unsigned*)(ws + WS_CTL) + 4096;
#pragma unroll
        for (int i = 0; i < 8; ++i) bz[F.tid + 512 * i] = 0u; }
    XcdBarrier xbar; xbar.bar = (unsigned*)(ws + WS_CTL) + 4096; xbar.x = xb_xcc_id(); xbar.st = (volatile LAS unsigned*)(F.lds + LDSCTL_OFF) + 8;
#else
    XcdBarrier xbar = xcd_barrier_post((unsigned*)(ws + WS_CTL) + 4096, (volatile LAS unsigned*)(F.lds + LDSCTL_OFF) + 8);
#endif
    int vb_ = F.bid; bool xl_ok = false;
#define LSEAM(k) do { if (IN(k) && IN((k) + 1)) { if (xl_ok) xcc_local_barrier(xbar, (unsigned)(F.G >> 3)); else xcd_barrier(xbar); } } while (0)
#define SEAM(k) do { if (IN(k) && IN((k) + 1)) { if ((k) == GSYNC_SEAM) cg::this_grid().sync(); else xcd_barrier(xbar); } } while (0)
    float* ss2 = (float*)(ws + WS_SS2); float* ss3 = (float*)(ws + WS_SS3);

#ifndef DUP_MASK
#define DUP_MASK 0
#endif
#define NREP(k) (1 + ((DUP_MASK >> (k)) & 1))
    if (IN(0)) { for (int rep = 0; rep < NREP(0); ++rep) p0_prologue(F); }
    SEAM(0);
#if MK_N_LAUNCHES == 1
    xbar = xcd_barrier_post(xbar.bar, xbar.st);
#endif
    const bool hsplit = F.G >= 128;
    pg8::EpiP1 EP1{(bf16_t*)(ws + WS_QT), (bf16_t*)(ws + WS_KT), (bf16_t*)(ws + WS_V), (bf16_t*)(ws + WS_SG), (bf16_t*)(ws + WS_SQ), (bf16_t*)(ws + WS_SK), (bf16_t*)(ws + WS_SV), (bf16_t*)(ws + WS_KVM),
                   (float*)(ws + WS_ELAST), (const float*)(ws + WS_LB), F.qng, F.kng, (const float*)(ws + WS_ROPE)};
    if (IN(1)) {
        pg8::Sched S; S.A0 = (const char*)(ws + WS_HN1); S.B0 = (const char*)(ws + WS_WIN); S.A1 = (const char*)(ws + WS_MN); S.B1 = (const char*)(ws + WS_WKV);
        S.nM0 = M / 256; S.nN0 = hsplit ? 8 : INW / 256; S.n0 = S.nM0 * S.nN0; S.n1 = hsplit ? 0 : (MM / 256) * 4; S.G = F.G; S.c = F.bid; S.tstep = (size_t)256 * D * 2; S.nrep = 1;
        pg8::gemm_phase<pg8::EpiP1, true, true>(F.lds, D, S, EP1);
    }
    SEAM(1);
    if (IN(2)) {
        if (hsplit) {
            if (F.bid < 64) { xcd_barrier_arrive(xbar); hgrn_mfma(F, F.bid >> 2, F.bid & 3); xcd_barrier_wait(xbar); }
            else {
                pg8::Sched S; S.A0 = (const char*)(ws + WS_HN1); S.B0 = (const char*)(ws + WS_WIN); S.A1 = (const char*)(ws + WS_MN); S.B1 = (const char*)(ws + WS_WKV);
                S.nM0 = M / 256; S.nN0 = INW / 256 - 8; S.pnoff = 8; S.n0 = S.nM0 * S.nN0; S.n1 = (MM / 256) * 4; S.G = F.G - 64; S.c = F.bid - 64; S.tstep = (size_t)256 * D * 2; S.nrep = 1;
                pg8::gemm_phase<pg8::EpiP1, true, true>(F.lds, D, S, EP1);
                __syncthreads();
                const int nu = S.n0 + S.n1, rem = nu % S.G, nlt = (rem == 0) ? S.G : S.G - rem, lt0 = (rem == 0) ? 0 : rem;
                if (S.c >= lt0) transpose_items(F, ITEMS_EARLY, ITEMS_ALL, (S.c - lt0) * 8 + F.wave, nlt * 8);
                xcd_barrier(xbar);
            }
            for (int u = F.bid; u < 512; u += F.G) swa_unit(F, u);
            __syncthreads();
            if (F.bid >= 64) kn_items(F, (F.bid - 64) * 8 + F.wave, (F.G - 64) * 8);
        } else {
            for (int u = F.bid; u < 64; u += F.G) hgrn_mfma(F, (u & 63) >> 2, u & 3);
            __syncthreads();
            for (int u = F.bid; u < 512; u += F.G) swa_unit(F, u & 511);
        }
    }
    SEAM(2);
    {
        volatile LAS unsigned* st_ = (volatile LAS unsigned*)(F.lds + LDSCTL_OFF) + 8;
        if (F.tid == 0) { unsigned ok = ((F.G & 7) == 0) ? 1u : 0u; const unsigned per = (unsigned)(F.G >> 3);
            for (unsigned j = 0; j < 16; ++j) { const unsigned c_ = xb_ld(&xbar.bar[XB_XCNT(j)]); if (c_ != (j < 8 ? per : 0u)) ok = 0u; }
            st_[3] = ok; }
        __syncthreads();
        xl_ok = st_[3] != 0u;
        if (xl_ok) vb_ = (int)xbar.x + 8 * (int)st_[2];
    }
    if (IN(3)) {
        pg8::Sched S; S.A0 = (const char*)(ws + WS_MIX); S.B0 = (const char*)(ws + WS_WOUT); S.A1 = S.A0; S.B1 = S.B0;
        S.nM0 = M / 256; S.nN0 = 4; S.n0 = S.nM0 * 4; S.n1 = 0; S.G = F.G; S.c = vb_; S.tstep = (size_t)256 * D * 2; S.nrep = NREP(3);
        pg8::EpiRes<false> E{F.x, nullptr, (bf16_t*)(ws + WS_HB), ss2};
        pg8::gemm_phase<pg8::EpiRes<false>, true, true>(F.lds, D, S, E);
    }
    LSEAM(3);
    if (IN(4)) {
        if (F.G < 128) for (int it = F.bid * 8 + F.wave; it < MM * 4; it += F.G * 8) kn_item(F, it);
        pg8::Sched S; S.A0 = (const char*)(ws + WS_HB); S.B0 = (const char*)(ws + WS_WQ); S.A1 = S.A0; S.B1 = S.B0;
        S.nM0 = M / 256; S.nN0 = 2; S.n0 = S.nM0 * 2; S.n1 = 0; S.G = F.G; S.c = vb_; S.tstep = (size_t)256 * D * 2; S.nrep = NREP(4);
        pg8::EpiScale<0> E{(bf16_t*)(ws + WS_QX), 512, ss2};
        pg8::gemm_phase<pg8::EpiScale<0>, true, true>(F.lds, D, S, E);
    }
    LSEAM(4);
    if (IN(5)) {
        for (int pr = xl_ok ? ((vb_ & 7) * (F.G >> 3) + (vb_ >> 3)) : F.bid; pr < 256; pr += F.G) xattn_pair(F, pr);
    }
    LSEAM(5);
    if (IN(6)) {
        pg8::Sched S; S.A0 = (const char*)(ws + WS_XO); S.B0 = (const char*)(ws + WS_WO); S.A1 = S.A0; S.B1 = S.B0;
        S.nM0 = M / 256; S.nN0 = 4; S.n0 = S.nM0 * 4; S.n1 = 0; S.G = F.G; S.c = vb_; S.tstep = (size_t)256 * 512 * 2; S.nrep = NREP(6);
        pg8::EpiRes<true> E{nullptr, (const bf16_t*)(ws + WS_HB), (bf16_t*)(ws + WS_HB), ss3};
        pg8::gemm_phase<pg8::EpiRes<true>, true, true>(F.lds, 512, S, E);
    }
    LSEAM(6);
    if (IN(7)) {
        pg8::Sched S; S.A0 = (const char*)(ws + WS_HB); S.B0 = (const char*)(ws + WS_WUP); S.A1 = S.A0; S.B1 = S.B0;
        S.nM0 = M / 256; S.nN0 = 16; S.n0 = S.nM0 * 16; S.n1 = 0; S.G = F.G; S.c = vb_; S.tstep = (size_t)256 * D * 2; S.nrep = NREP(7);
        pg8::EpiScale<1> E{(bf16_t*)(ws + WS_ACT), FF, ss3};
        pg8::gemm_phase<pg8::EpiScale<1>, true, true>(F.lds, D, S, E);
    }
    LSEAM(7);
    if (IN(8)) {
        pg8::Sched S; S.A0 = (const char*)(ws + WS_ACT); S.B0 = (const char*)(ws + WS_WDN); S.A1 = S.A0; S.B1 = S.B0;
        S.nM0 = M / 256; S.nN0 = 4; S.n0 = S.nM0 * 4; S.n1 = 0; S.G = F.G; S.c = vb_; S.tstep = (size_t)256 * FF * 2; S.nrep = NREP(8);
        pg8::EpiAdd E{(const bf16_t*)(ws + WS_HB), F.out, ss3};
        pg8::gemm_phase<pg8::EpiAdd, true, true>(F.lds, FF, S, E);
    }
#undef IN
#undef SEAM
}

extern "C" void kernel_launch(void* const* d_in, const int* in_sizes, int n_in, void* d_out, int out_size, void* d_ws, size_t ws_size, hipStream_t stream) {
    static int grid = 0;
    if (grid == 0) {
        if (n_in != 21 || in_sizes[0] != M * D || out_size != M * D || ws_size < WS_END) { fprintf(stderr, "kernel_launch: unexpected shapes (n_in %d, ws %zu)\n", n_in, ws_size); grid = -1; return; }
        int dev = 0, cus = 0, per_cu = 0;
        (void)hipGetDevice(&dev); (void)hipDeviceGetAttribute(&cus, hipDeviceAttributeMultiprocessorCount, dev);
        (void)hipFuncSetAttribute((const void*)layer_fwd, hipFuncAttributeMaxDynamicSharedMemorySize, LDS_BYTES);
        (void)hipOccupancyMaxActiveBlocksPerMultiprocessor(&per_cu, (const void*)layer_fwd, 512, LDS_BYTES);
        if (per_cu < 1) per_cu = 1;
        if (per_cu > 1) per_cu = 1;
        grid = cus * per_cu; (void)hipGetLastError();
    }
    if (grid < 0) return;
#if MK_N_LAUNCHES != 1
    (void)hipMemsetAsync((char*)d_ws + WS_CTL, 0, CTL_ZERO_BYTES, stream);
#endif
    Args a{};
    for (int i = 0; i < 21; ++i) a.in[i] = d_in[i];
    a.out = (float*)d_out; a.ws = (unsigned char*)d_ws;
#if MK_N_LAUNCHES == 1
    a.ph_lo = 0; a.ph_hi = NPHASE;
    void* kargs[] = {&a};
    hipError_t e = hipLaunchCooperativeKernel((const void*)layer_fwd, dim3(grid), dim3(512), kargs, LDS_BYTES, stream);
    if (e != hipSuccess) fprintf(stderr, "cooperative launch failed: %s (grid %d)\n", hipGetErrorString(e), grid);
#else
    for (int p = 0; p < NPHASE; ++p) { a.ph_lo = p; a.ph_hi = p + 1; hipLaunchKernelGGL(layer_fwd, dim3(grid), dim3(512), LDS_BYTES, stream, a); }
#endif
}
```

```cpp
#include <hip/hip_runtime.h>
#include <hip/hip_cooperative_groups.h>
#include <cstdio>
#include <cstdint>
namespace cg = cooperative_groups;

#ifndef DIS_MASK
#define DIS_MASK 0
#endif
#ifndef MK_N_LAUNCHES
#define MK_N_LAUNCHES 1
#endif

#define LAS __attribute__((address_space(3)))
#define GAS __attribute__((address_space(1)))
typedef unsigned short bf16_t;
typedef short bf16x8 __attribute__((ext_vector_type(8)));
typedef float f32x4 __attribute__((ext_vector_type(4)));
typedef unsigned u32x4 __attribute__((ext_vector_type(4)));
typedef unsigned u32x2 __attribute__((ext_vector_type(2)));

constexpr int D = 1024, BATCH = 16, SEQ = 2048, M = BATCH * SEQ, MEMLEN = 256, MM = BATCH * MEMLEN;
constexpr int INW = 2816, FF = 4096;
constexpr float EPS = 1e-6f;

constexpr size_t MiB = 1u << 20;
constexpr size_t WS_CTL = 0, CTL_ZERO_BYTES = 64 * 1024;
constexpr size_t WS_SS2 = 1 * MiB, WS_SS3 = 1 * MiB + 256 * 1024;
constexpr size_t WS_LB = 1 * MiB + 512 * 1024;
constexpr size_t WS_WIN = 2 * MiB;
constexpr size_t WS_WOUT = WS_WIN + (size_t)INW * D * 2;
constexpr size_t WS_WQ = WS_WOUT + (size_t)D * D * 2;
constexpr size_t WS_WKV = WS_WQ + (size_t)512 * D * 2;
constexpr size_t WS_WO = WS_WKV + (size_t)D * D * 2;
constexpr size_t WS_WUP = WS_WO + (size_t)D * 512 * 2;
constexpr size_t WS_WDN = WS_WUP + (size_t)FF * D * 2;
constexpr size_t WS_ROPE = 30 * MiB;
constexpr size_t WS_KVM = 32 * MiB;
constexpr size_t WS_ELAST = 40 * MiB;
constexpr size_t WS_KN = 42 * MiB;
constexpr size_t WS_HB = 48 * MiB;
constexpr size_t WS_QX = 112 * MiB;
constexpr size_t WS_XO = 144 * MiB;
constexpr size_t WS_MIX = 176 * MiB;
constexpr size_t WS_R = 240 * MiB;
constexpr size_t WS_HN1 = WS_R;
constexpr size_t WS_MN = WS_R + 64 * MiB;
constexpr size_t WS_QT = WS_R + 72 * MiB;
constexpr size_t WS_KT = WS_R + 104 * MiB;
constexpr size_t WS_V = WS_R + 136 * MiB;
constexpr size_t WS_SG = WS_R + 168 * MiB;
constexpr size_t WS_SQ = WS_R + 200 * MiB;
constexpr size_t WS_SK = WS_R + 232 * MiB;
constexpr size_t WS_SV = WS_R + 240 * MiB;
constexpr size_t WS_ACT = WS_R;
constexpr size_t WS_END = WS_R + 256 * MiB;
static_assert(WS_WDN + (size_t)D * FF * 2 <= WS_ROPE, "weights fit");

constexpr int RING_BYTES = 131072, LDSCTL_OFF = 151552, LDS_BYTES = 155648;

__device__ __forceinline__ unsigned f2bf(float f) { unsigned u = __builtin_bit_cast(unsigned, f); return (u + 0x7fffu + ((u >> 16) & 1u)) >> 16; }
__device__ __forceinline__ unsigned pk2(float lo, float hi) { return f2bf(lo) | (f2bf(hi) << 16); }
__device__ __forceinline__ float bf2f(unsigned short b) { return __builtin_bit_cast(float, (unsigned)b << 16); }
__device__ __forceinline__ float bflo(unsigned w) { return __builtin_bit_cast(float, w << 16); }
__device__ __forceinline__ float bfhi(unsigned w) { return __builtin_bit_cast(float, w & 0xffff0000u); }
__device__ __forceinline__ unsigned cvt_pk_bf16(float lo, float hi) { unsigned r; asm volatile("v_cvt_pk_bf16_f32 %0, %1, %2" : "=v"(r) : "v"(lo), "v"(hi)); return r; }
__device__ __forceinline__ u32x4 pack8(const f32x4& a, const f32x4& b) { u32x4 w; w.x = cvt_pk_bf16(a[0], a[1]); w.y = cvt_pk_bf16(a[2], a[3]); w.z = cvt_pk_bf16(b[0], b[1]); w.w = cvt_pk_bf16(b[2], b[3]); return w; }
__device__ __forceinline__ float wave_sum(float v) {
#pragma unroll
    for (int o = 1; o < 64; o <<= 1) v += __shfl_xor(v, o);
    return v;
}
__device__ __forceinline__ float wave_max(float v) {
#pragma unroll
    for (int o = 1; o < 64; o <<= 1) v = fmaxf(v, __shfl_xor(v, o));
    return v;
}
__device__ __forceinline__ float fexp(float x) { return __builtin_amdgcn_exp2f(x * 1.4426950408889634f); }
__device__ __forceinline__ float frcp(float x) { return __builtin_amdgcn_rcpf(x); }
__device__ __forceinline__ float frsq(float x) { return __builtin_amdgcn_rsqf(x); }
__device__ __forceinline__ float flog(float x) { return __builtin_amdgcn_logf(x) * 0.6931471805599453f; }
template <int N> __device__ __forceinline__ float dpp_row_shr(float v) {
    return __builtin_bit_cast(float, __builtin_amdgcn_update_dpp(0, __builtin_bit_cast(int, v), 0x110 + N, 0xf, 0xf, false));
}
template <int N> __device__ __forceinline__ float dpp_row_shr1(float v) {
    return __builtin_bit_cast(float, __builtin_amdgcn_update_dpp(0x3f800000, __builtin_bit_cast(int, v), 0x110 + N, 0xf, 0xf, false));
}
__device__ __forceinline__ float row16_prefix_mul(float p) {
    p *= dpp_row_shr1<1>(p); p *= dpp_row_shr1<2>(p); p *= dpp_row_shr1<4>(p); p *= dpp_row_shr1<8>(p); return p;
}
__device__ __forceinline__ float row16_prefix(float p) {
    p += dpp_row_shr<1>(p); p += dpp_row_shr<2>(p); p += dpp_row_shr<4>(p); p += dpp_row_shr<8>(p); return p;
}

namespace pg8 {
constexpr int BM = 256, BK = 64, HALF = 128, HTB = HALF * BK * 2, NXCD = 8, WGM = 8;
__host__ __device__ __forceinline__ int lds_byte(int r, int c) { const int st = (r >> 4) * 2 + (c >> 5), rr = r & 15, cc = c & 31, ob = rr * 64 + cc * 2; return st * 1024 + (ob ^ (((ob >> 9) & 1) << 5)); }
__host__ __device__ __forceinline__ void stage_rc(int b, int& R, int& C) { const int st = b / 1024, sb = b % 1024, swz = sb ^ (((sb >> 9) & 1) << 5); R = (st >> 1) * 16 + swz / 64; C = (st & 1) * 32 + (swz % 64) / 2; }
__host__ __device__ __forceinline__ int perm32(int rho) { const int n = rho >> 4, i = rho & 15; return 8 * (i >> 2) + 4 * n + (i & 3); }

struct Unit { int pm, pn, kind; };
__device__ __forceinline__ void map_tile(int L, int nM, int nN, int& pm, int& pn) {
    const int nwg = nM * nN; int wgid = L;
    { const int q = nwg / NXCD, r = nwg % NXCD, xcd = wgid % NXCD, off = wgid / NXCD; wgid = (xcd < r ? xcd * (q + 1) : r * (q + 1) + (xcd - r) * q) + off; }
    const int nig = WGM * nN, gid = wgid / nig, fm = gid * WGM, gsz = (nM - fm) < WGM ? (nM - fm) : WGM;
    pm = fm + ((wgid % nig) % gsz); pn = (wgid % nig) / gsz;
}
struct Sched {
    const char *A0, *B0, *A1, *B1; int nM0, nN0, n0, n1, G, c; size_t tstep; int nrep; int pnoff = 0;
    __device__ __forceinline__ bool next(int i, Unit& u) const {
        int L = i * G + c;
        if (nrep > 1) { if (L < n0 * nrep) { const int pass = L / n0; map_tile(L - pass * n0, nM0, nN0, u.pm, u.pn); u.kind = (pass + 1 < nrep) ? 2 : 0; return true; } L -= n0 * (nrep - 1); }
        if (L < n0) { map_tile(L, nM0, nN0, u.pm, u.pn); u.pn += pnoff; u.kind = 0; return true; }
        if (L < n0 + n1) { const int idx = L - n0; u.pm = idx >> 2; u.pn = idx & 3; u.kind = 1; return true; }
        return false;
    }
    __device__ __forceinline__ const char* aptr(const Unit& u) const { return (u.kind == 1 ? A1 : A0) + (size_t)u.pm * tstep; }
    __device__ __forceinline__ const char* bptr(const Unit& u) const { return (u.kind == 1 ? B1 : B0) + (size_t)u.pn * tstep; }
};

template <class Epi, bool ALIGN_EPI, bool SP2>
__device__ __forceinline__ void gemm_phase(LAS unsigned char* lds, const int K, const Sched& S, const Epi& E) {
    const int tid = threadIdx.x, wid = __builtin_amdgcn_readfirstlane(tid >> 6), lane = tid & 63, wr = wid >> 2, wc = wid & 3, fr = lane & 15, fq = lane >> 4;
    const int nt = K / BK;
    unsigned voffA[2], voffB[2];
#pragma unroll
    for (int i = 0; i < 2; ++i) { int R, C; stage_rc(tid * 16 + i * 8192, R, C); const int Rb = (R & ~31) + perm32(R & 31);
        voffA[i] = (unsigned)(R * K + C) * 2u; voffB[i] = (unsigned)(Rb * K + C) * 2u; }
    const size_t kstep = (size_t)(BK * 2);
    const size_t hstep = (size_t)HALF * K * 2;
    const unsigned ldsw = (unsigned)wid * 1024u;
    const int aoff = lds_byte(wr * 64 + fr, fq * 8), boff = lds_byte(wc * 32 + fr, fq * 8);
#define PG8_SA(b, h) (((b) * 2 + (h)) * HTB)
#define PG8_SB(b, h) ((4 + (b) * 2 + (h)) * HTB)
#define PG8_STAGE(bufoff, gbase, voff) do { _Pragma("unroll") for (int _i = 0; _i < 2; ++_i) \
        __builtin_amdgcn_global_load_lds((const unsigned*)((const char*)(gbase) + (voff)[_i]), (LAS unsigned*)(lds + (bufoff) + ldsw + _i * 8192), 16, 0, 0); } while (0)
#define PG8_LDA(dst, b, h) do { _Pragma("unroll") for (int m = 0; m < 4; ++m) _Pragma("unroll") for (int k = 0; k < 2; ++k) dst[m][k] = *(const LAS bf16x8*)(lds + PG8_SA(b, h) + aoff + m * 2048 + k * 1024); } while (0)
#define PG8_LDB(dst, b, h) do { _Pragma("unroll") for (int n = 0; n < 2; ++n) _Pragma("unroll") for (int k = 0; k < 2; ++k) dst[n][k] = *(const LAS bf16x8*)(lds + PG8_SB(b, h) + boff + n * 2048 + k * 1024); } while (0)
#define PG8_MMA(ai, bj, At, Bt) do { __builtin_amdgcn_s_setprio(1); _Pragma("unroll") for (int m = 0; m < 4; ++m) _Pragma("unroll") for (int n = 0; n < 2; ++n) _Pragma("unroll") for (int k = 0; k < 2; ++k) \
        acc[ai][bj][m][n] = __builtin_amdgcn_mfma_f32_16x16x32_bf16(Bt[n][k], At[m][k], acc[ai][bj][m][n], 0, 0, 0); __builtin_amdgcn_s_setprio(0); } while (0)
#define PG8_WAIT_V(n) asm volatile("s_waitcnt vmcnt(" #n ")" ::: "memory")
#define PG8_WAIT_L(n) asm volatile("s_waitcnt lgkmcnt(" #n ")" ::: "memory")
#define PG8_BAR __builtin_amdgcn_s_barrier()
#define PG8_SCHED __builtin_amdgcn_sched_barrier(0)
    Unit cur, nxt; int ui = 0;
    if (!S.next(0, cur)) return;
    f32x4 acc[2][2][4][2];
#pragma unroll
    for (int a = 0; a < 2; ++a)
#pragma unroll
        for (int b = 0; b < 2; ++b)
#pragma unroll
            for (int m = 0; m < 4; ++m)
#pragma unroll
                for (int n = 0; n < 2; ++n) acc[a][b][m][n] = (f32x4){0.f, 0.f, 0.f, 0.f};
    bf16x8 At[4][2], B0[2][2], B1[2][2];
    const char* cA = S.aptr(cur); const char* cB = S.bptr(cur);
    if constexpr (SP2) {
        PG8_STAGE(PG8_SB(0, 0), cB, voffB); PG8_STAGE(PG8_SB(0, 1), cB + hstep, voffB); PG8_STAGE(PG8_SA(0, 0), cA, voffA); PG8_STAGE(PG8_SA(0, 1), cA + hstep, voffA);
        if (wr == 1) PG8_BAR;
        PG8_WAIT_V(2); PG8_BAR;
        PG8_STAGE(PG8_SB(1, 0), cB + kstep, voffB); PG8_STAGE(PG8_SA(1, 0), cA + kstep, voffA); PG8_STAGE(PG8_SB(1, 1), cB + hstep + kstep, voffB);
        PG8_WAIT_V(6); PG8_BAR;
    } else {
        PG8_STAGE(PG8_SB(0, 0), cB, voffB); PG8_STAGE(PG8_SA(0, 0), cA, voffA); PG8_STAGE(PG8_SB(0, 1), cB + hstep, voffB); PG8_STAGE(PG8_SA(0, 1), cA + hstep, voffA);
        if (wr == 1) PG8_BAR;
        PG8_WAIT_V(4); PG8_BAR;
        PG8_STAGE(PG8_SB(1, 0), cB + kstep, voffB); PG8_STAGE(PG8_SA(1, 0), cA + kstep, voffA); PG8_STAGE(PG8_SB(1, 1), cB + hstep + kstep, voffB);
        PG8_WAIT_V(6); PG8_BAR;
    }
    for (;;) {
        const bool has_next = S.next(ui + 1, nxt);
        const char* nA = has_next ? S.aptr(nxt) : cA; const char* nB = has_next ? S.bptr(nxt) : cB;
        for (int t = 0; t < nt; t += 2) {
            const bool last = (t == nt - 2);
            const char* a1 = cA + (size_t)(t + 1) * kstep;
            const char* a2 = last ? nA : cA + (size_t)(t + 2) * kstep; const char* b2 = last ? nB : cB + (size_t)(t + 2) * kstep;
            const char* a3 = a2 + kstep; const char* b3 = b2 + kstep;
            if constexpr (SP2) {
            PG8_LDB(B0, 0, 0); PG8_LDB(B1, 0, 1); PG8_SCHED; PG8_LDA(At, 0, 0); PG8_STAGE(PG8_SA(1, 1), a1 + hstep, voffA);
            PG8_WAIT_V(8); PG8_WAIT_L(0); PG8_BAR; PG8_MMA(0, 0, At, B0); PG8_MMA(0, 1, At, B1); PG8_BAR; PG8_SCHED;
            PG8_LDA(At, 0, 1); PG8_STAGE(PG8_SB(0, 0), b2, voffB); PG8_STAGE(PG8_SB(0, 1), b2 + hstep, voffB); PG8_STAGE(PG8_SA(0, 0), a2, voffA);
            PG8_WAIT_V(8); PG8_WAIT_L(0); PG8_BAR; PG8_MMA(1, 0, At, B0); PG8_MMA(1, 1, At, B1); PG8_BAR; PG8_SCHED;
            PG8_LDB(B0, 1, 0); PG8_LDB(B1, 1, 1); PG8_SCHED; PG8_LDA(At, 1, 0); PG8_STAGE(PG8_SA(0, 1), a2 + hstep, voffA);
            PG8_WAIT_V(8); PG8_WAIT_L(0); PG8_BAR; PG8_MMA(0, 0, At, B0); PG8_MMA(0, 1, At, B1); PG8_BAR; PG8_SCHED;
            PG8_LDA(At, 1, 1); PG8_STAGE(PG8_SB(1, 0), b3, voffB); PG8_STAGE(PG8_SB(1, 1), b3 + hstep, voffB); PG8_STAGE(PG8_SA(1, 0), a3, voffA);
            PG8_WAIT_V(8); PG8_WAIT_L(0); PG8_BAR; PG8_MMA(1, 0, At, B0); PG8_MMA(1, 1, At, B1); PG8_BAR; PG8_SCHED;
            } else {
            PG8_LDB(B0, 0, 0); PG8_SCHED; PG8_LDA(At, 0, 0); PG8_STAGE(PG8_SA(1, 1), a1 + hstep, voffA);
            PG8_WAIT_L(8); PG8_BAR; PG8_WAIT_L(0); PG8_MMA(0, 0, At, B0); PG8_BAR; PG8_SCHED;
            PG8_LDB(B1, 0, 1); PG8_STAGE(PG8_SB(0, 0), b2, voffB);
            PG8_BAR; PG8_WAIT_L(0); PG8_MMA(0, 1, At, B1); PG8_BAR;
            PG8_LDA(At, 0, 1); PG8_STAGE(PG8_SA(0, 0), a2, voffA);
            PG8_BAR; PG8_WAIT_L(0); PG8_MMA(1, 0, At, B0); PG8_BAR; PG8_SCHED;
            PG8_STAGE(PG8_SB(0, 1), b2 + hstep, voffB);
            PG8_WAIT_V(6); PG8_BAR; PG8_MMA(1, 1, At, B1); PG8_BAR;
            PG8_LDB(B0, 1, 0); PG8_SCHED; PG8_LDA(At, 1, 0); PG8_STAGE(PG8_SA(0, 1), a2 + hstep, voffA);
            PG8_WAIT_L(8); PG8_BAR; PG8_WAIT_L(0); PG8_MMA(0, 0, At, B0); PG8_BAR; PG8_SCHED;
            PG8_LDB(B1, 1, 1); PG8_STAGE(PG8_SB(1, 0), b3, voffB);
            PG8_BAR; PG8_WAIT_L(0); PG8_MMA(0, 1, At, B1); PG8_BAR;
            PG8_LDA(At, 1, 1); PG8_STAGE(PG8_SA(1, 0), a3, voffA);
            PG8_BAR; PG8_WAIT_L(0); PG8_MMA(1, 0, At, B0); PG8_BAR; PG8_SCHED;
            PG8_STAGE(PG8_SB(1, 1), b3 + hstep, voffB);
            PG8_WAIT_V(6); PG8_BAR; PG8_MMA(1, 1, At, B1); PG8_BAR;
            }
        }
        if constexpr (ALIGN_EPI) { if (wr == 0) PG8_BAR; }
        E(acc, cur, wr, wc, fr, fq);
        if (!has_next) break;
#pragma unroll
        for (int a = 0; a < 2; ++a)
#pragma unroll
            for (int b = 0; b < 2; ++b)
#pragma unroll
                for (int m = 0; m < 4; ++m)
#pragma unroll
                    for (int n = 0; n < 2; ++n) acc[a][b][m][n] = (f32x4){0.f, 0.f, 0.f, 0.f};
        cur = nxt; cA = nA; cB = nB; ++ui;
        if constexpr (ALIGN_EPI) { if (wr == 1) PG8_BAR; }
    }
    PG8_WAIT_V(0);
    if constexpr (!ALIGN_EPI) { if (wr == 0) PG8_BAR; }
    PG8_BAR;
#undef PG8_SA
#undef PG8_SB
#undef PG8_STAGE
#undef PG8_LDA
#undef PG8_LDB
#undef PG8_MMA
#undef PG8_WAIT_V
#undef PG8_WAIT_L
#undef PG8_BAR
#undef PG8_SCHED
}

typedef f32x4 Acc[2][2][4][2];

struct EpiP1 {
    bf16_t *QT, *KT, *V, *SG, *SQ, *SK, *SV, *KVM; float* ELAST;
    const float *LB, *qng, *kng, *rope;
    __device__ __forceinline__ void operator()(Acc& acc, const Unit& u, int wr, int wc, int fr, int fq) const {
        asm volatile("" : "+v"(fr), "+v"(fq));
        const int row0 = u.pm * BM + wr * 64 + fr;
        const int cw = wc * 32 + 8 * fq;
        if (u.kind == 1) {
#pragma unroll
            for (int ai = 0; ai < 2; ++ai)
#pragma unroll
                for (int m = 0; m < 4; ++m)
#pragma unroll
                    for (int bj = 0; bj < 2; ++bj) *(u32x4*)(KVM + (size_t)(row0 + ai * HALF + m * 16) * 1024 + u.pn * 256 + bj * HALF + cw) = pack8(acc[ai][bj][m][0], acc[ai][bj][m][1]);
            return;
        }
        const int pn = u.pn;
        if (pn < 4 && !(DIS_MASK & 1)) {
            const int hk0 = pn * 128 + cw;
            const f32x4 lb4[2] = {*(const f32x4*)(LB + hk0), *(const f32x4*)(LB + hk0 + 4)};
#pragma unroll
            for (int ai = 0; ai < 2; ++ai) {
                f32x4 el[2];
#pragma unroll
                for (int n = 0; n < 2; ++n)
#pragma unroll
                    for (int i = 0; i < 4; ++i) {
                        const float lbv = lb4[n][i], oml = 1.0f - lbv;
                        float carry = 1.f;
#pragma unroll
                        for (int m = 0; m < 4; ++m) {
                            float x = acc[ai][1][m][n][i]; x = fminf(fmaxf(x, -30.f), 30.f);
                            const float ex = fexp(-x), s = frcp(1.0f + ex);
                            const float f = lbv + oml * s, kk = oml * ex * s;
                            const float p = row16_prefix_mul(f);
                            const float eb = carry * p;
                            carry *= __shfl(p, 15, 16);
                            float qv = acc[ai][0][m][n][i] * eb, kv = kk * frcp(eb);
                            asm volatile("" : "+v"(qv), "+v"(kv));
                            acc[ai][0][m][n][i] = qv; acc[ai][1][m][n][i] = kv;
                        }
                        el[n][i] = carry;
                        __builtin_amdgcn_sched_barrier(0);
                    }
                if (fr == 0) { float* ep = ELAST + (size_t)(u.pm * 4 + ai * 2 + wr) * 512 + hk0; *(f32x4*)ep = el[0]; *(f32x4*)(ep + 4) = el[1]; }
#pragma unroll
                for (int m = 0; m < 4; ++m) { const size_t o = (size_t)(row0 + ai * HALF + m * 16) * 512 + hk0;
                    *(u32x4*)(QT + o) = pack8(acc[ai][0][m][0], acc[ai][0][m][1]); *(u32x4*)(KT + o) = pack8(acc[ai][1][m][0], acc[ai][1][m][1]); }
            }
        } else if (pn < 6) {
#pragma unroll
            for (int ai = 0; ai < 2; ++ai)
#pragma unroll
                for (int m = 0; m < 4; ++m)
#pragma unroll
                    for (int bj = 0; bj < 2; ++bj) *(u32x4*)(V + (size_t)(row0 + ai * HALF + m * 16) * 512 + (pn - 4) * 256 + bj * HALF + cw) = pack8(acc[ai][bj][m][0], acc[ai][bj][m][1]);
        } else if (pn < 8 && !(DIS_MASK & 2)) {
#pragma unroll
            for (int ai = 0; ai < 2; ++ai)
#pragma unroll
                for (int m = 0; m < 4; ++m)
#pragma unroll
                    for (int bj = 0; bj < 2; ++bj) { f32x4 a = acc[ai][bj][m][0], b = acc[ai][bj][m][1];
#pragma unroll
                        for (int i = 0; i < 4; ++i) { a[i] = a[i] * frcp(1.0f + fexp(-a[i])); b[i] = b[i] * frcp(1.0f + fexp(-b[i])); }
                        *(u32x4*)(SG + (size_t)(row0 + ai * HALF + m * 16) * 512 + (pn - 6) * 256 + bj * HALF + cw) = pack8(a, b); }
        } else {
            const bool isv = (pn == 10) && (wc >= 2);
            if (isv || (DIS_MASK & 4)) {
#pragma unroll
                for (int ai = 0; ai < 2; ++ai)
#pragma unroll
                    for (int m = 0; m < 4; ++m)
#pragma unroll
                        for (int bj = 0; bj < 2; ++bj) *(u32x4*)(SV + (size_t)(row0 + ai * HALF + m * 16) * 128 + (wc - 2) * 64 + bj * 32 + 8 * fq) = pack8(acc[ai][bj][m][0], acc[ai][bj][m][1]);
            } else {
                const bool isk = (pn == 10);
                const float* gp = isk ? kng : qng; const float osc = isk ? 1.0f : 0.125f * 1.4426950408889634f;
                f32x4 g[2][2];
#pragma unroll
                for (int bj = 0; bj < 2; ++bj)
#pragma unroll
                    for (int n = 0; n < 2; ++n) g[bj][n] = *(const f32x4*)(gp + bj * 32 + 8 * fq + 4 * n) * osc;
                bf16_t* ob = isk ? (SK + wc * 64 + 8 * fq) : (SQ + (pn - 8) * 256 + wc * 64 + 8 * fq); const int ld = isk ? 128 : 512;
#pragma unroll
                for (int ai = 0; ai < 2; ++ai)
#pragma unroll
                    for (int m = 0; m < 4; ++m) {
                        const int row = row0 + ai * HALF + m * 16;
                        float ss = 0.f;
#pragma unroll
                        for (int bj = 0; bj < 2; ++bj)
#pragma unroll
                            for (int n = 0; n < 2; ++n) { const f32x4 v = acc[ai][bj][m][n]; ss += (v[0] * v[0] + v[1] * v[1]) + (v[2] * v[2] + v[3] * v[3]); }
                        ss += __shfl_xor(ss, 16); ss += __shfl_xor(ss, 32);
                        const float rstd = frsq(ss * (1.0f / 64.0f) + EPS);
                        f32x4 y[2][2];
#pragma unroll
                        for (int bj = 0; bj < 2; ++bj)
#pragma unroll
                            for (int n = 0; n < 2; ++n) y[bj][n] = acc[ai][bj][m][n] * rstd * g[bj][n];
                        const float* rp = rope + (size_t)row * 16;
#pragma unroll
                        for (int n = 0; n < 2; ++n) {
                            const f32x4 cs = *(const f32x4*)(rp + 4 * n), sn = *(const f32x4*)(rp + 8 + 4 * n);
                            f32x4 o;
#pragma unroll
                            for (int i = 0; i < 4; ++i) { const float mine = y[0][n][i], oth = __shfl_xor(mine, 16);
                                const float r = (fq == 0) ? (mine * cs[i] - oth * sn[i]) : (mine * cs[i] + oth * sn[i]);
                                o[i] = (fq < 2) ? r : mine; }
                            y[0][n] = o;
                        }
#pragma unroll
                        for (int bj = 0; bj < 2; ++bj) *(u32x4*)(ob + (size_t)row * ld + bj * 32) = pack8(y[bj][0], y[bj][1]);
                    }
            }
        }
    }
};

template <bool BASE_BF16> struct EpiRes {
    const float* basef; const bf16_t* baseb; bf16_t* hb; float* sumsq;
    __device__ __forceinline__ void operator()(Acc& acc, const Unit& u, int wr, int wc, int fr, int fq) const {
        asm volatile("" : "+v"(fr), "+v"(fq));
        const int row0 = u.pm * BM + wr * 64 + fr, col0 = u.pn * BM + wc * 32 + 8 * fq;
        if constexpr (BASE_BF16) {
            u32x4 rw[2][4][2];
#pragma unroll
            for (int ai = 0; ai < 2; ++ai)
#pragma unroll
                for (int m = 0; m < 4; ++m)
#pragma unroll
                    for (int bj = 0; bj < 2; ++bj) rw[ai][m][bj] = *(const u32x4*)(baseb + (size_t)(row0 + ai * HALF + m * 16) * D + col0 + bj * HALF);
            __builtin_amdgcn_sched_barrier(0);
#pragma unroll
            for (int ai = 0; ai < 2; ++ai)
#pragma unroll
                for (int m = 0; m < 4; ++m) { const int row = row0 + ai * HALF + m * 16; const size_t o = (size_t)row * D + col0; float ss = 0.f;
#pragma unroll
                    for (int bj = 0; bj < 2; ++bj) { const u32x4 w = rw[ai][m][bj];
                        const f32x4 h0 = (f32x4){bflo(w.x), bfhi(w.x), bflo(w.y), bfhi(w.y)} + acc[ai][bj][m][0], h1 = (f32x4){bflo(w.z), bfhi(w.z), bflo(w.w), bfhi(w.w)} + acc[ai][bj][m][1];
                        *(u32x4*)(hb + o + bj * HALF) = pack8(h0, h1);
                        ss += (h0[0] * h0[0] + h0[1] * h0[1]) + (h0[2] * h0[2] + h0[3] * h0[3]) + (h1[0] * h1[0] + h1[1] * h1[1]) + (h1[2] * h1[2] + h1[3] * h1[3]); }
                    ss += __shfl_xor(ss, 16); ss += __shfl_xor(ss, 32);
                    if (fq == 0) atomicAdd(sumsq + row, ss); }
        } else {
#pragma unroll
            for (int ai = 0; ai < 2; ++ai) {
                f32x4 rx[4][2][2];
#pragma unroll
                for (int m = 0; m < 4; ++m)
#pragma unroll
                    for (int bj = 0; bj < 2; ++bj) { const float* p = basef + (size_t)(row0 + ai * HALF + m * 16) * D + col0 + bj * HALF; rx[m][bj][0] = *(const f32x4*)p; rx[m][bj][1] = *(const f32x4*)(p + 4); }
                __builtin_amdgcn_sched_barrier(0);
#pragma unroll
                for (int m = 0; m < 4; ++m) { const int row = row0 + ai * HALF + m * 16; const size_t o = (size_t)row * D + col0; float ss = 0.f;
#pragma unroll
                    for (int bj = 0; bj < 2; ++bj) { const f32x4 h0 = rx[m][bj][0] + acc[ai][bj][m][0], h1 = rx[m][bj][1] + acc[ai][bj][m][1];
                        *(u32x4*)(hb + o + bj * HALF) = pack8(h0, h1);
                        ss += (h0[0] * h0[0] + h0[1] * h0[1]) + (h0[2] * h0[2] + h0[3] * h0[3]) + (h1[0] * h1[0] + h1[1] * h1[1]) + (h1[2] * h1[2] + h1[3] * h1[3]); }
                    ss += __shfl_xor(ss, 16); ss += __shfl_xor(ss, 32);
                    if (fq == 0) atomicAdd(sumsq + row, ss); }
                __builtin_amdgcn_sched_barrier(0);
            }
        }
    }
};
template <int ACT> struct EpiScale {
    bf16_t* O; int ldc; const float* sumsq;
    __device__ __forceinline__ void operator()(Acc& acc, const Unit& u, int wr, int wc, int fr, int fq) const {
        asm volatile("" : "+v"(fr), "+v"(fq));
        const int row0 = u.pm * BM + wr * 64 + fr, col0 = u.pn * BM + wc * 32 + 8 * fq;
        float ssv[2][4];
        if (ACT == 0) {
#pragma unroll
            for (int ai = 0; ai < 2; ++ai)
#pragma unroll
                for (int m = 0; m < 4; ++m) ssv[ai][m] = sumsq[row0 + ai * HALF + m * 16];
            __builtin_amdgcn_sched_barrier(0);
        }
#pragma unroll
        for (int ai = 0; ai < 2; ++ai)
#pragma unroll
            for (int m = 0; m < 4; ++m) { const int row = row0 + ai * HALF + m * 16; const float rstd = (ACT == 0) ? frsq(ssv[ai][m] * (1.0f / D) + EPS) : 1.0f;
#pragma unroll
                for (int bj = 0; bj < 2; ++bj) { f32x4 a = acc[ai][bj][m][0] * rstd, b = acc[ai][bj][m][1] * rstd;
                    if (ACT == 1) {
#pragma unroll
                        for (int i = 0; i < 4; ++i) { const float x = fmaxf(a[i], 0.f), y = fmaxf(b[i], 0.f); a[i] = x * x; b[i] = y * y; } }
                    *(u32x4*)(O + (size_t)row * ldc + col0 + bj * HALF) = pack8(a, b); }
            }
    }
};
struct EpiAdd {
    const bf16_t* baseb; float* out; const float* sumsq;
    __device__ __forceinline__ void operator()(Acc& acc, const Unit& u, int wr, int wc, int fr, int fq) const {
        asm volatile("" : "+v"(fr), "+v"(fq));
        const int row0 = u.pm * BM + wr * 64 + fr, col0 = u.pn * BM + wc * 32 + 8 * fq;
        u32x4 rw[2][4][2]; float ssv[2][4];
#pragma unroll
        for (int ai = 0; ai < 2; ++ai)
#pragma unroll
            for (int m = 0; m < 4; ++m) { ssv[ai][m] = sumsq[row0 + ai * HALF + m * 16];
#pragma unroll
                for (int bj = 0; bj < 2; ++bj) rw[ai][m][bj] = *(const u32x4*)(baseb + (size_t)(row0 + ai * HALF + m * 16) * D + col0 + bj * HALF); }
        __builtin_amdgcn_sched_barrier(0);
#pragma unroll
        for (int ai = 0; ai < 2; ++ai)
#pragma unroll
            for (int m = 0; m < 4; ++m) { const size_t o_ = (size_t)(row0 + ai * HALF + m * 16) * D + col0; const float r2 = 1.0f / (ssv[ai][m] * (1.0f / D) + EPS);
#pragma unroll
                for (int bj = 0; bj < 2; ++bj) { const u32x4 w = rw[ai][m][bj];
                    const f32x4 h0 = (f32x4){bflo(w.x), bfhi(w.x), bflo(w.y), bfhi(w.y)} + acc[ai][bj][m][0] * r2, h1 = (f32x4){bflo(w.z), bfhi(w.z), bflo(w.w), bfhi(w.w)} + acc[ai][bj][m][1] * r2;
                    *(f32x4*)(out + o_ + bj * HALF) = h0; *(f32x4*)(out + o_ + bj * HALF + 4) = h1; } }
    }
};
}


#define XB_TMO      128
#define XB_XCNT(j)  (256  + 64 * (j))
#define XB_XSUB(j)  (1280 + 64 * (j))
#define XB_XGEN(j)  (2304 + 64 * (j))
#define XB_TOP      3328
#define XB_TOPGEN   3392
#define XB_SPIN_CAP (1u << 18)
__device__ __forceinline__ unsigned xb_ld(unsigned* p)              { return __hip_atomic_load(p, __ATOMIC_RELAXED, __HIP_MEMORY_SCOPE_AGENT); }
__device__ __forceinline__ unsigned xb_add(unsigned* p, unsigned v) { return __hip_atomic_fetch_add(p, v, __ATOMIC_RELAXED, __HIP_MEMORY_SCOPE_AGENT); }
__device__ __forceinline__ unsigned xb_xcc_id() { return (unsigned)__builtin_amdgcn_s_getreg((3 << 11) | 20) & 0xFu; }
#define XB_SPIN(cond, bar) do { unsigned _sp = 0; while (cond) { __builtin_amdgcn_s_sleep(1); \
    if ((++_sp & 255u) == 0u) { if (xb_ld(&(bar)[XB_TMO])) break; if (_sp > XB_SPIN_CAP) { atomicAdd(&(bar)[XB_TMO], 1u); break; } } } } while (0)
struct XcdBarrier { unsigned* bar; unsigned x; volatile LAS unsigned* st; };
__device__ __forceinline__ XcdBarrier xcd_barrier_post(unsigned* bar, volatile LAS unsigned* st) {
    XcdBarrier b; b.bar = bar; b.x = xb_xcc_id(); b.st = st;
    if (threadIdx.x == 0) st[2] = xb_add(&bar[XB_XCNT(b.x)], 1u);
    return b;
}
#define XB_LCNT(j)  (3456 + 64 * (j))
__device__ __forceinline__ void xcc_local_barrier(const XcdBarrier& b, unsigned nloc) {
    asm volatile("s_waitcnt vmcnt(0)" ::: "memory");
    __syncthreads();
    if (threadIdx.x == 0) {
        __builtin_amdgcn_s_waitcnt(0);
        const unsigned old = xb_add(&b.bar[XB_LCNT(b.x)], 1u);
        const unsigned target = (old / nloc + 1u) * nloc;
        XB_SPIN(xb_ld(&b.bar[XB_LCNT(b.x)]) < target, b.bar);
        __builtin_amdgcn_fence(__ATOMIC_ACQUIRE, "agent");
        asm volatile("s_waitcnt vmcnt(0)" ::: "memory");
    }
    __syncthreads();
}
__device__ __forceinline__ void xcd_barrier_complete(unsigned* bar, unsigned x, unsigned& nloc, unsigned& nx) {
    const unsigned G = gridDim.x * gridDim.y * gridDim.z;
    unsigned sum, cnt, mine, sp = 0u;
    for (;;) {
        sum = 0u; cnt = 0u; mine = 0u;
#pragma unroll
        for (unsigned j = 0; j < 16; ++j) { const unsigned c = xb_ld(&bar[XB_XCNT(j)]); sum += c; cnt += (c > 0u) ? 1u : 0u; mine = (j == x) ? c : mine; }
        if (sum == G) break;
        __builtin_amdgcn_s_sleep(1);
        if ((++sp & 255u) == 0u) { if (xb_ld(&bar[XB_TMO])) break; if (sp > XB_SPIN_CAP) { atomicAdd(&bar[XB_TMO], 1u); break; } }
    }
    nloc = mine > 0u ? mine : 1u; nx = cnt > 0u ? cnt : 1u;
}
__device__ __forceinline__ void xcd_barrier_arrive(const XcdBarrier& b) {
    asm volatile("s_waitcnt vmcnt(0)" ::: "memory");
    __syncthreads();
    if (threadIdx.x == 0) {
        unsigned* bar = b.bar;
        __builtin_amdgcn_s_waitcnt(0);
        unsigned nloc = b.st[0], nx = b.st[1];
        if (nloc == 0u) { xcd_barrier_complete(bar, b.x, nloc, nx); b.st[0] = nloc; b.st[1] = nx; }
        const unsigned old = xb_add(&bar[XB_XSUB(b.x)], 1u);
        const unsigned gen = old / nloc;
        if (old + 1u == (gen + 1u) * nloc) {
            __builtin_amdgcn_fence(__ATOMIC_RELEASE, "agent");
            asm volatile("s_waitcnt vmcnt(0)" ::: "memory");
            const unsigned og = xb_add(&bar[XB_TOP], 1u);
            const unsigned tg = og / nx;
            if (og + 1u == (tg + 1u) * nx) xb_add(&bar[XB_TOPGEN], 1u);
            else XB_SPIN(xb_ld(&bar[XB_TOPGEN]) == tg, bar);
            xb_add(&bar[XB_XGEN(b.x)], 1u);
            asm volatile("s_waitcnt vmcnt(0)" ::: "memory");
            b.st[5] = 1u;
        } else b.st[5] = 0u;
        b.st[4] = gen;
    }
}
__device__ __forceinline__ void xcd_barrier_wait(const XcdBarrier& b) {
    asm volatile("s_waitcnt vmcnt(0)" ::: "memory");
    __syncthreads();
    if (threadIdx.x == 0) {
        if (b.st[5] == 0u) { const unsigned gen = b.st[4]; XB_SPIN(xb_ld(&b.bar[XB_XGEN(b.x)]) == gen, b.bar); }
        __builtin_amdgcn_fence(__ATOMIC_ACQUIRE, "agent");
        asm volatile("s_waitcnt vmcnt(0)" ::: "memory");
    }
    __syncthreads();
}
__device__ __forceinline__ void xcd_barrier(const XcdBarrier& b) {
    asm volatile("s_waitcnt vmcnt(0)" ::: "memory");
    __syncthreads();
    if (threadIdx.x == 0) {
        unsigned* bar = b.bar;
        __builtin_amdgcn_s_waitcnt(0);
        unsigned nloc = b.st[0], nx = b.st[1];
        if (nloc == 0u) { xcd_barrier_complete(bar, b.x, nloc, nx); b.st[0] = nloc; b.st[1] = nx; }
        const unsigned old = xb_add(&bar[XB_XSUB(b.x)], 1u);
        const unsigned gen = old / nloc;
        if (old + 1u == (gen + 1u) * nloc) {
            __builtin_amdgcn_fence(__ATOMIC_RELEASE, "agent");
            asm volatile("s_waitcnt vmcnt(0)" ::: "memory");
            const unsigned og = xb_add(&bar[XB_TOP], 1u);
            const unsigned tg = og / nx;
            if (og + 1u == (tg + 1u) * nx) xb_add(&bar[XB_TOPGEN], 1u);
            else XB_SPIN(xb_ld(&bar[XB_TOPGEN]) == tg, bar);
            __builtin_amdgcn_fence(__ATOMIC_ACQUIRE, "agent");
            xb_add(&bar[XB_XGEN(b.x)], 1u);
            asm volatile("s_waitcnt vmcnt(0)" ::: "memory");
        } else {
            XB_SPIN(xb_ld(&bar[XB_XGEN(b.x)]) == gen, bar);
            __builtin_amdgcn_fence(__ATOMIC_ACQUIRE, "agent");
            asm volatile("s_waitcnt vmcnt(0)" ::: "memory");
        }
    }
    __syncthreads();
}

struct Args { const void* in[21]; float* out; unsigned char* ws; int ph_lo, ph_hi; };
struct Frame {
    LAS unsigned char* lds; int tid, lane, wave, G, bid;
    const float *x, *mem, *g1, *w_in, *hlb, *hng, *qng, *kng, *sinks, *w_out, *g2, *gm, *wq, *wkv, *xqg, *xkg, *wo, *g3, *wup, *wdn; const int* pos;
    float* out; unsigned char* ws;
};

__device__ __forceinline__ void p0_transpose_item(const float* W, int K, int N, bf16_t* WT, int dest_row0, const float* gain, LAS float* scr, int k0, int n0, int lane) {
    float wv[32];
#pragma unroll
    for (int i = 0; i < 32; ++i) { const int kk = 2 * i + (lane >> 5); wv[i] = W[(size_t)(k0 + kk) * N + n0 + (lane & 31)]; }
    if (gain) {
#pragma unroll
        for (int i = 0; i < 32; ++i) wv[i] *= gain[k0 + 2 * i + (lane >> 5)]; }
#pragma unroll
    for (int i = 0; i < 32; ++i) { const int kk = 2 * i + (lane >> 5); scr[kk * 33 + (lane & 31)] = wv[i]; }
    asm volatile("s_waitcnt lgkmcnt(0)" ::: "memory");
    const int c = lane & 7;
#pragma unroll
    for (int j = 0; j < 4; ++j) { const int n = (lane >> 3) + 8 * j; const LAS float* s = scr + (8 * c) * 33 + n;
        u32x4 o; o.x = pk2(s[0 * 33], s[1 * 33]); o.y = pk2(s[2 * 33], s[3 * 33]); o.z = pk2(s[4 * 33], s[5 * 33]); o.w = pk2(s[6 * 33], s[7 * 33]);
        *(u32x4*)(WT + (size_t)(dest_row0 + n) * K + k0 + 8 * c) = o; }
    asm volatile("s_waitcnt lgkmcnt(0)" ::: "memory");
}
__device__ __forceinline__ int win_dest(int c) {
    if (c < 512) return 256 * (c >> 7) + (c & 127);
    if (c < 1024) { const int cc = c - 512; return 256 * (cc >> 7) + 128 + (cc & 127); }
    if (c < 2048) return c;
    const int base = (c < 2560) ? 2048 + 256 * ((c - 2048) >> 8) : 2560;
    const int L = (c < 2560) ? ((c - 2048) & 255) : (c - 2560);
    const int wc = L >> 6, bj = (L & 63) >> 5;
    return base + 128 * bj + 32 * wc + (L & 31);
}
template <int NR> __device__ __forceinline__ void rms_rows_to_bf16(const float* x, const float* g, bf16_t* o, int row0, int rstride, int nrows, int lane) {
    f32x4 v[NR][4];
#pragma unroll
    for (int r = 0; r < NR; ++r) { const int rr = (row0 + r * rstride < nrows) ? row0 + r * rstride : row0; const f32x4* xr = (const f32x4*)(x + (size_t)rr * D) + lane;
#pragma unroll
        for (int j = 0; j < 4; ++j) v[r][j] = xr[64 * j]; }
    __builtin_amdgcn_sched_barrier(0);
    const f32x4* gr = (const f32x4*)g + lane;
    f32x4 gg[4];
#pragma unroll
    for (int j = 0; j < 4; ++j) gg[j] = gr[64 * j];
#pragma unroll
    for (int r = 0; r < NR; ++r) { float s = 0.f;
#pragma unroll
        for (int j = 0; j < 4; ++j) s += (v[r][j].x * v[r][j].x + v[r][j].y * v[r][j].y) + (v[r][j].z * v[r][j].z + v[r][j].w * v[r][j].w);
        const float rstd = 1.f / sqrtf(wave_sum(s) * (1.f / D) + EPS);
        if (row0 + r * rstride >= nrows) continue;
        u32x2* o8 = (u32x2*)(o + (size_t)(row0 + r * rstride) * D) + lane;
#pragma unroll
        for (int j = 0; j < 4; ++j) { u32x2 w; w.x = pk2(v[r][j].x * rstd * gg[j].x, v[r][j].y * rstd * gg[j].y); w.y = pk2(v[r][j].z * rstd * gg[j].z, v[r][j].w * rstd * gg[j].w); o8[64 * j] = w; } }
}
constexpr int I_IN = 16 * 88, I_KV = 16 * 32, I_OUT = 16 * 32, I_Q = 16 * 16, I_O = 8 * 32, I_UP = 16 * 128, I_DN = 64 * 32;
constexpr int ITEMS_EARLY = I_IN + I_KV, ITEMS_ALL = ITEMS_EARLY + I_OUT + I_Q + I_O + I_UP + I_DN;
__device__ __forceinline__ void transpose_items(Frame& F, int it0, int it1, int gw, int NGW) {
    LAS float* scr = (LAS float*)(F.lds + F.wave * 16384);
    bf16_t* Win_t = (bf16_t*)(F.ws + WS_WIN); bf16_t* Wout_t = (bf16_t*)(F.ws + WS_WOUT); bf16_t* Wq_t = (bf16_t*)(F.ws + WS_WQ); bf16_t* Wkv_t = (bf16_t*)(F.ws + WS_WKV);
    bf16_t* Wo_t = (bf16_t*)(F.ws + WS_WO); bf16_t* Wup_t = (bf16_t*)(F.ws + WS_WUP); bf16_t* Wdn_t = (bf16_t*)(F.ws + WS_WDN);
    for (int it = it0 + gw; it < it1; it += NGW) {
        int r = it;
        if (r < I_IN) { const int kb = r / 88, nb = r % 88; p0_transpose_item(F.w_in, D, INW, Win_t, win_dest(32 * nb), nullptr, scr, 64 * kb, 32 * nb, F.lane); continue; } r -= I_IN;
        if (r < I_KV) { const int kb = r / 32, nb = r % 32; p0_transpose_item(F.wkv, D, D, Wkv_t, 32 * nb, nullptr, scr, 64 * kb, 32 * nb, F.lane); continue; } r -= I_KV;
        if (r < I_OUT) { const int kb = r / 32, nb = r % 32; p0_transpose_item(F.w_out, D, D, Wout_t, 32 * nb, nullptr, scr, 64 * kb, 32 * nb, F.lane); continue; } r -= I_OUT;
        if (r < I_Q) { const int kb = r / 16, nb = r % 16; p0_transpose_item(F.wq, D, 512, Wq_t, 32 * nb, F.g2, scr, 64 * kb, 32 * nb, F.lane); continue; } r -= I_Q;
        if (r < I_O) { const int kb = r / 32, nb = r % 32; p0_transpose_item(F.wo, 512, D, Wo_t, 32 * nb, nullptr, scr, 64 * kb, 32 * nb, F.lane); continue; } r -= I_O;
        if (r < I_UP) { const int kb = r / 128, nb = r % 128; p0_transpose_item(F.wup, D, FF, Wup_t, 32 * nb, F.g3, scr, 64 * kb, 32 * nb, F.lane); continue; } r -= I_UP;
        { const int kb = r / 32, nb = r % 32; p0_transpose_item(F.wdn, FF, D, Wdn_t, 32 * nb, nullptr, scr, 64 * kb, 32 * nb, F.lane); }
    }
}
__device__ __forceinline__ void p0_prologue(Frame& F) {
    const int gw = F.bid * 8 + F.wave, NGW = F.G * 8;
    transpose_items(F, 0, (F.G >= 128) ? ITEMS_EARLY : ITEMS_ALL, gw, NGW);
    bf16_t* HN1 = (bf16_t*)(F.ws + WS_HN1); bf16_t* MN = (bf16_t*)(F.ws + WS_MN);
    for (int m = gw; m < M; m += 8 * NGW) rms_rows_to_bf16<8>(F.x, F.g1, HN1, m, NGW, M, F.lane);
    for (int m = gw; m < MM; m += 2 * NGW) rms_rows_to_bf16<2>(F.mem, F.gm, MN, m, NGW, MM, F.lane);
    for (int e = F.bid * 512 + F.tid; e < 2 * 65536; e += F.G * 512) ((float*)(F.ws + WS_SS2))[e] = 0.f;
    float* rope = (float*)(F.ws + WS_ROPE);
    for (int e = F.bid * 512 + F.tid; e < M * 8; e += F.G * 512) { const int row = e >> 3, j = e & 7;
        const double inv_rev = (double)exp2f(-(float)j * (0.125f * 18.931568569324174f)) * 0.15915494309189535;
        const double rev = (double)F.pos[row] * inv_rev; const float fr = (float)(rev - rint(rev));
        rope[row * 16 + j] = __builtin_amdgcn_cosf(fr); rope[row * 16 + 8 + j] = __builtin_amdgcn_sinf(fr); }
    if (F.bid == 0) { float* LB = (float*)(F.ws + WS_LB); for (int k = F.tid; k < 512; k += 512) LB[k] = 1.0f / (1.0f + expf(F.hlb[512 + k] - F.hlb[k])); }
}

__device__ __forceinline__ void hgrn_simple(Frame& F, int b, int h) {
    LAS float* qs = (LAS float*)F.lds; LAS float* ks = qs + 64 * 128; LAS float* vs = ks + 64 * 128; LAS float* op = vs + 64 * 128;
    const bf16_t* QT = (const bf16_t*)(F.ws + WS_QT); const bf16_t* KT = (const bf16_t*)(F.ws + WS_KT); const bf16_t* V = (const bf16_t*)(F.ws + WS_V); const bf16_t* SG = (const bf16_t*)(F.ws + WS_SG);
    const float* ELAST = (const float*)(F.ws + WS_ELAST); bf16_t* MIX = (bf16_t*)(F.ws + WS_MIX);
    const int v = F.tid & 127, kg = F.tid >> 7;
    float S[32];
#pragma unroll
    for (int i = 0; i < 32; ++i) S[i] = 0.f;
    for (int c = 0; c < 32; ++c) {
        const int row0 = b * SEQ + c * 64;
        __syncthreads();
        for (int e = F.tid; e < 64 * 128; e += 512) { const int t = e >> 7, k = e & 127; const size_t o = (size_t)(row0 + t) * 512 + h * 128 + k;
            qs[e] = bf2f(QT[o]); ks[e] = bf2f(KT[o]); vs[e] = bf2f(V[o]); }
        __syncthreads();
        for (int tg = 0; tg < 4; ++tg) {
            for (int tt = 0; tt < 16; ++tt) { const int t = tg * 16 + tt; const float vv = vs[t * 128 + v]; float ao = 0.f;
#pragma unroll
                for (int kk = 0; kk < 32; ++kk) { S[kk] += ks[t * 128 + 32 * kg + kk] * vv; ao += S[kk] * qs[t * 128 + 32 * kg + kk]; }
                op[(kg * 16 + tt) * 128 + v] = ao; }
            __syncthreads();
#pragma unroll
            for (int rr = 0; rr < 2; ++rr) { const int tt = F.wave * 2 + rr, row = row0 + tg * 16 + tt;
                float o0 = 0.f, o1 = 0.f;
#pragma unroll
                for (int g = 0; g < 4; ++g) { o0 += op[(g * 16 + tt) * 128 + F.lane]; o1 += op[(g * 16 + tt) * 128 + F.lane + 64]; }
                const float rstd = 1.0f / sqrtf(wave_sum(o0 * o0 + o1 * o1) * (1.0f / 128.0f) + EPS);
                const size_t so = (size_t)row * 512 + h * 128;
                MIX[(size_t)row * 1024 + h * 128 + F.lane] = (bf16_t)f2bf(o0 * rstd * F.hng[F.lane] * bf2f(SG[so + F.lane]));
                MIX[(size_t)row * 1024 + h * 128 + F.lane + 64] = (bf16_t)f2bf(o1 * rstd * F.hng[F.lane + 64] * bf2f(SG[so + F.lane + 64])); }
            __syncthreads();
        }
        const float* el = ELAST + (size_t)(row0 >> 6) * 512 + h * 128 + 32 * kg;
#pragma unroll
        for (int kk = 0; kk < 32; ++kk) S[kk] *= el[kk];
    }
}
__device__ __forceinline__ void swa_simple(Frame& F, int row, int hq) {
    const bf16_t* SQ = (const bf16_t*)(F.ws + WS_SQ); const bf16_t* SK = (const bf16_t*)(F.ws + WS_SK); const bf16_t* SV = (const bf16_t*)(F.ws + WS_SV); bf16_t* MIX = (bf16_t*)(F.ws + WS_MIX);
    const int t = row & (SEQ - 1), kvh = hq >> 2, lane = F.lane;
    const float q = bf2f(SQ[(size_t)row * 512 + hq * 64 + lane]);
    const int nk = (t + 1 < 128) ? t + 1 : 128; const int r0 = row - nk + 1;
    float s0 = -INFINITY, s1 = -INFINITY;
    for (int j = 0; j < nk; ++j) { const float d = wave_sum(q * bf2f(SK[(size_t)(r0 + j) * 128 + kvh * 64 + lane]));
        if (lane == (j & 63)) { if (j < 64) s0 = d; else s1 = d; } }
    const float sink = F.sinks[hq] * 1.4426950408889634f;
    const float mx = fmaxf(wave_max(fmaxf(s0, s1)), sink);
    const float p0 = exp2f(s0 - mx), p1 = exp2f(s1 - mx);
    const float den = wave_sum(p0 + p1) + exp2f(sink - mx);
    float o = 0.f;
    for (int j = 0; j < nk; ++j) { const float p = __shfl(j < 64 ? p0 : p1, j & 63); o += p * bf2f(SV[(size_t)(r0 + j) * 128 + kvh * 64 + lane]); }
    MIX[(size_t)row * 1024 + 512 + hq * 64 + lane] = (bf16_t)f2bf(o / den);
}
__device__ __forceinline__ void kn_item(Frame& F, int item) {
    const bf16_t* KVM = (const bf16_t*)(F.ws + WS_KVM); bf16_t* KN = (bf16_t*)(F.ws + WS_KN);
    const int r = item >> 2, h = item & 3, lane = F.lane;
    const unsigned w = *(const unsigned*)(KVM + (size_t)r * 1024 + h * 128 + 2 * lane);
    const float a = bflo(w), b = bfhi(w);
    const float rstd = 1.0f / sqrtf(wave_sum(a * a + b * b) * (1.0f / 128.0f) + EPS);
    *(unsigned*)(KN + (size_t)r * 512 + h * 128 + 2 * lane) = pk2(a * rstd * F.xkg[2 * lane], b * rstd * F.xkg[2 * lane + 1]);
}
__device__ __forceinline__ void kn_items(Frame& F, int it0, int stride) {
    const bf16_t* KVM = (const bf16_t*)(F.ws + WS_KVM); bf16_t* KN = (bf16_t*)(F.ws + WS_KN);
    const int lane = F.lane; const float g0 = F.xkg[2 * lane], g1 = F.xkg[2 * lane + 1];
    for (int it = it0; it < MM * 4; it += 4 * stride) {
        unsigned w[4];
#pragma unroll
        for (int j = 0; j < 4; ++j) { const int item = it + j * stride; w[j] = (item < MM * 4) ? *(const unsigned*)(KVM + (size_t)(item >> 2) * 1024 + (item & 3) * 128 + 2 * lane) : 0u; }
        __builtin_amdgcn_sched_barrier(0);
#pragma unroll
        for (int j = 0; j < 4; ++j) { const int item = it + j * stride; const float a = bflo(w[j]), b = bfhi(w[j]);
            const float rstd = 1.0f / sqrtf(wave_sum(a * a + b * b) * (1.0f / 128.0f) + EPS);
            if (item < MM * 4) *(unsigned*)(KN + (size_t)(item >> 2) * 512 + (item & 3) * 128 + 2 * lane) = pk2(a * rstd * g0, b * rstd * g1); }
    }
}
__device__ __forceinline__ void xattn_simple(Frame& F, int row, int h) {
    const bf16_t* QX = (const bf16_t*)(F.ws + WS_QX); const bf16_t* KN = (const bf16_t*)(F.ws + WS_KN); const bf16_t* KVM = (const bf16_t*)(F.ws + WS_KVM); bf16_t* XO = (bf16_t*)(F.ws + WS_XO);
    const int b = row >> 11, lane = F.lane;
    const unsigned qw = *(const unsigned*)(QX + (size_t)row * 512 + h * 128 + 2 * lane);
    float q0 = bflo(qw), q1 = bfhi(qw);
    const float rstd = 1.0f / sqrtf(wave_sum(q0 * q0 + q1 * q1) * (1.0f / 128.0f) + EPS) * 0.08838834764831845f;
    q0 *= rstd * F.xqg[2 * lane]; q1 *= rstd * F.xqg[2 * lane + 1];
    float s[4] = {0.f, 0.f, 0.f, 0.f};
    for (int mm = 0; mm < 256; ++mm) { const unsigned kw = *(const unsigned*)(KN + (size_t)(b * 256 + mm) * 512 + h * 128 + 2 * lane);
        const float d = wave_sum(q0 * bflo(kw) + q1 * bfhi(kw));
        if (lane == (mm & 63)) {
#pragma unroll
            for (int g = 0; g < 4; ++g) if (g == (mm >> 6)) s[g] = d; } }
    const float mx = wave_max(fmaxf(fmaxf(s[0], s[1]), fmaxf(s[2], s[3])));
    float p[4]; float ps = 0.f;
#pragma unroll
    for (int g = 0; g < 4; ++g) { p[g] = __expf(s[g] - mx); ps += p[g]; }
    const float den = wave_sum(ps);
    float o0 = 0.f, o1 = 0.f;
#pragma unroll
    for (int g = 0; g < 4; ++g)
        for (int j = 0; j < 64; ++j) { const float pj = __shfl(p[g], j); const unsigned vw = *(const unsigned*)(KVM + (size_t)(b * 256 + g * 64 + j) * 1024 + 512 + h * 128 + 2 * lane);
            o0 += pj * bflo(vw); o1 += pj * bfhi(vw); }
    *(unsigned*)(XO + (size_t)row * 512 + h * 128 + 2 * lane) = pk2(o0 / den, o1 / den);
}


typedef float f32x16 __attribute__((ext_vector_type(16)));
typedef short s16x4 __attribute__((ext_vector_type(4)));
typedef short v4i16_t __attribute__((ext_vector_type(4)));
typedef float f32x2_t __attribute__((ext_vector_type(2)));
typedef __bf16 bf16x2_t __attribute__((ext_vector_type(2)));
#define MFMA32(a, b, c) __builtin_amdgcn_mfma_f32_32x32x16_bf16((a), (b), (c), 0, 0, 0)
__device__ __forceinline__ unsigned cvtpk(float lo, float hi) { f32x2_t v = {lo, hi}; bf16x2_t b = __builtin_convertvector(v, bf16x2_t); return __builtin_bit_cast(unsigned, b); }
__device__ __forceinline__ s16x4 ds_tr(const LAS unsigned char* p) { return __builtin_bit_cast(s16x4, __builtin_amdgcn_ds_read_tr16_b64_v4i16((LAS v4i16_t*)p)); }
__device__ __forceinline__ bf16x8 cat8(s16x4 lo, s16x4 hi) { return (bf16x8){lo[0], lo[1], lo[2], lo[3], hi[0], hi[1], hi[2], hi[3]}; }
__device__ __forceinline__ bf16x8 pack_step(const f32x16& x, int s) {
    u32x4 p; p.x = cvtpk(x[8 * s], x[8 * s + 1]); p.y = cvtpk(x[8 * s + 2], x[8 * s + 3]); p.z = cvtpk(x[8 * s + 4], x[8 * s + 5]); p.w = cvtpk(x[8 * s + 6], x[8 * s + 7]);
    return __builtin_bit_cast(bf16x8, p);
}
template <int RB> __device__ __forceinline__ unsigned offa(unsigned row, unsigned ch) { return RB * (row >> 3) + 512u * (ch >> 2) + 64u * (row & 7) + 16u * ((ch & 3) ^ ((row >> 2) & 3)); }

__device__ __forceinline__ void xattn_pair(Frame& F, int pair) {
    const bf16_t* QX = (const bf16_t*)(F.ws + WS_QX); const bf16_t* KN = (const bf16_t*)(F.ws + WS_KN); const bf16_t* KVM = (const bf16_t*)(F.ws + WS_KVM); bf16_t* XO = (bf16_t*)(F.ws + WS_XO);
    int lane = F.lane; asm volatile("" : "+v"(lane));
    const int bh = pair >> 2, b = bh >> 2, h = bh & 3, r32 = lane & 31, hi = lane >> 5;
    LAS unsigned char* Kimg = F.lds; LAS unsigned char* Vimg = F.lds + 65536; LAS unsigned char* stg = F.lds + 131072 + F.wave * 2560;
    __syncthreads();
    {
        u32x4 kt_[8], vt_[8];
#pragma unroll
        for (int it = 0; it < 8; ++it) { const int i = F.wave * 64 + lane + 512 * it, key = i >> 4, ch = i & 15;
            kt_[it] = *(const u32x4*)(KN + (size_t)(b * 256 + key) * 512 + h * 128 + 8 * ch);
            vt_[it] = *(const u32x4*)(KVM + (size_t)(b * 256 + key) * 1024 + 512 + h * 128 + 8 * ch); }
#pragma unroll
        for (int it = 0; it < 8; ++it) { const int i = F.wave * 64 + lane + 512 * it, key = i >> 4, ch = i & 15;
            *(LAS u32x4*)(Kimg + offa<2048>(key, ch)) = kt_[it]; *(LAS u32x4*)(Vimg + offa<2048>(key, ch)) = vt_[it]; }
    }
    __syncthreads();
    const float gqm = wave_max(fmaxf(fabsf(F.xqg[lane]), fabsf(F.xqg[lane + 64]))), gkm = wave_max(fmaxf(fabsf(F.xkg[lane]), fabsf(F.xkg[lane + 64])));
    const float C2 = 11.313708498984761f * gqm * gkm * 1.4426950408889634f;
    const unsigned kb = 2048u * (r32 >> 3) + 64u * (r32 & 7), xk = (r32 >> 2) & 3;
    const unsigned kbe = kb + 16u * ((unsigned)hi ^ xk), kbo = kb + 16u * ((2u + hi) ^ xk);
    const unsigned q4 = (lane & 15) >> 2, p4 = lane & 3, blk = (lane >> 4) & 1;
    const unsigned vb = 64u * (4 * hi + q4) + 8u * (p4 & 1), vc = 2 * blk + (p4 >> 1);
    const unsigned vb0 = vb + 16u * (vc ^ (unsigned)hi), vb1 = vb + 2048u + 16u * (vc ^ (2u + hi));
    for (int qq = 0; qq < 2; ++qq) {
        const int R0 = b * SEQ + ((pair & 3) * 2 + qq) * 256 + F.wave * 32;
        const bf16_t* qp = QX + (size_t)(R0 + r32) * 512 + h * 128 + 8 * hi;
        u32x4 qraw[8]; float ss = 0.f;
#pragma unroll
        for (int ks = 0; ks < 8; ++ks) { qraw[ks] = *(const u32x4*)(qp + 16 * ks);
#pragma unroll
            for (int j = 0; j < 4; ++j) { const float a = bflo(qraw[ks][j]), c = bfhi(qraw[ks][j]); ss += a * a + c * c; } }
        ss += __shfl_xor(ss, 32);
        const float sc = frsq(ss * (1.0f / 128.0f) + EPS) * (0.08838834764831845f * 1.4426950408889634f);
        bf16x8 qf[8];
#pragma unroll
        for (int ks = 0; ks < 8; ++ks) { const f32x4 g0 = *(const f32x4*)(F.xqg + 16 * ks + 8 * hi), g1 = *(const f32x4*)(F.xqg + 16 * ks + 8 * hi + 4);
            u32x4 w; w.x = cvtpk(bflo(qraw[ks].x) * sc * g0[0], bfhi(qraw[ks].x) * sc * g0[1]); w.y = cvtpk(bflo(qraw[ks].y) * sc * g0[2], bfhi(qraw[ks].y) * sc * g0[3]);
            w.z = cvtpk(bflo(qraw[ks].z) * sc * g1[0], bfhi(qraw[ks].z) * sc * g1[1]); w.w = cvtpk(bflo(qraw[ks].w) * sc * g1[2], bfhi(qraw[ks].w) * sc * g1[3]);
            qf[ks] = __builtin_bit_cast(bf16x8, w); }
        f32x16 o[4]; float lsum = 0.f;
#pragma unroll
        for (int c = 0; c < 4; ++c)
#pragma unroll
            for (int r = 0; r < 16; ++r) o[c][r] = 0.f;
        bf16x8 kf[8];
#pragma unroll
        for (int ks = 0; ks < 8; ++ks) kf[ks] = *(const LAS bf16x8*)(Kimg + ((ks & 1) ? kbo : kbe) + 512 * (ks >> 1));
        for (int kt = 0; kt < 8; ++kt) {
            const LAS unsigned char* Kn = Kimg + ((kt < 7) ? kt + 1 : kt) * 8192; const LAS unsigned char* Vt = Vimg + kt * 8192;
            f32x16 acc;
#pragma unroll
            for (int r = 0; r < 16; ++r) acc[r] = -C2;
#pragma unroll
            for (int ks = 0; ks < 8; ++ks) acc = MFMA32(kf[ks], qf[ks], acc);
            __builtin_amdgcn_sched_barrier(0);
            bf16x8 vf[2][4];
#pragma unroll
            for (int s = 0; s < 2; ++s)
#pragma unroll
                for (int c = 0; c < 4; ++c) vf[s][c] = cat8(ds_tr(Vt + s * 4096 + c * 512 + vb0), ds_tr(Vt + s * 4096 + c * 512 + vb1));
#pragma unroll
            for (int ks = 0; ks < 8; ++ks) kf[ks] = *(const LAS bf16x8*)(Kn + ((ks & 1) ? kbo : kbe) + 512 * (ks >> 1));
            __builtin_amdgcn_sched_barrier(0);
#pragma unroll
            for (int r = 0; r < 16; ++r) { acc[r] = __builtin_amdgcn_exp2f(acc[r]); lsum += acc[r]; }
            const bf16x8 pa0 = pack_step(acc, 0), pa1 = pack_step(acc, 1);
#pragma unroll
            for (int s = 0; s < 2; ++s)
#pragma unroll
                for (int c = 0; c < 4; ++c) o[c] = MFMA32(vf[s][c], s ? pa1 : pa0, o[c]);
        }
        lsum += __shfl_xor(lsum, 32);
        const float inv = frcp(lsum);
#pragma unroll
        for (int c = 0; c < 4; ++c) {
#pragma unroll
            for (int g = 0; g < 4; ++g) { u32x2 w; w.x = cvtpk(o[c][4 * g] * inv, o[c][4 * g + 1] * inv); w.y = cvtpk(o[c][4 * g + 2] * inv, o[c][4 * g + 3] * inv);
                *(LAS u32x2*)(stg + r32 * 80 + (8 * g + 4 * hi) * 2) = w; }
#pragma unroll
            for (int j = 0; j < 2; ++j) { const int idx = lane + 64 * j, row = idx >> 2, c8 = idx & 3;
                const u32x4 v = *(const LAS u32x4*)(stg + row * 80 + 16 * c8);
                *(u32x4*)(XO + (size_t)(R0 + row) * 512 + h * 128 + 32 * c + 8 * c8) = v; }
        }
    }
}

__device__ __forceinline__ void swa_unit(Frame& F, int u) {
    const bf16_t* SQ = (const bf16_t*)(F.ws + WS_SQ); const bf16_t* SK = (const bf16_t*)(F.ws + WS_SK); const bf16_t* SV = (const bf16_t*)(F.ws + WS_SV); bf16_t* MIX = (bf16_t*)(F.ws + WS_MIX);
    int lane = F.lane; asm volatile("" : "+v"(lane));
    const int b = u >> 5, n = (u >> 1) & 15, kvh = u & 1, r32 = lane & 31, hi = lane >> 5;
    LAS unsigned char* Kimg = F.lds; LAS unsigned char* Vimg = F.lds + 32768; LAS unsigned char* stg = F.lds + 65536 + F.wave * 4608;
    __syncthreads();
    {
        u32x4 kt_[4], vt_[4];
#pragma unroll
        for (int it = 0; it < 4; ++it) { const int i = F.wave * 64 + lane + 512 * it, key = i >> 3, ch = i & 7;
            const int keyl = (n > 0 || key >= 128) ? key : key + 128; const size_t row = (size_t)b * SEQ + (n - 1) * 128 + keyl;
            kt_[it] = *(const u32x4*)(SK + row * 128 + kvh * 64 + 8 * ch); vt_[it] = *(const u32x4*)(SV + row * 128 + kvh * 64 + 8 * ch); }
#pragma unroll
        for (int it = 0; it < 4; ++it) { const int i = F.wave * 64 + lane + 512 * it, key = i >> 3, ch = i & 7;
            *(LAS u32x4*)(Kimg + offa<1024>(key, ch)) = kt_[it]; *(LAS u32x4*)(Vimg + offa<1024>(key, ch)) = vt_[it]; }
    }
    __syncthreads();
    const int hq = kvh * 4 + (F.wave >> 1);
    const float gqm = wave_max(fabsf(F.qng[lane])), gkm = wave_max(fabsf(F.kng[lane]));
    const float sinkv = F.sinks[hq];
    const float C2 = fmaxf(8.0f * gqm * gkm, sinkv) * 1.4426950408889634f;
    const unsigned kb = 1024u * (r32 >> 3) + 64u * (r32 & 7), xk = (r32 >> 2) & 3;
    const unsigned kbe = kb + 16u * ((unsigned)hi ^ xk), kbo = kb + 16u * ((2u + hi) ^ xk);
    const unsigned q4 = (lane & 15) >> 2, p4 = lane & 3, blk = (lane >> 4) & 1;
    const unsigned vb = 64u * (4 * hi + q4) + 8u * (p4 & 1), vc = 2 * blk + (p4 >> 1);
    const unsigned vb0 = vb + 16u * (vc ^ (unsigned)hi), vb1 = vb + 1024u + 16u * (vc ^ (2u + hi));
    for (int aa = 0; aa < 2; ++aa) {
        const int a = (F.wave & 1) * 2 + aa;
        const int R0 = b * SEQ + n * 128 + 32 * a;
        const bf16_t* qp = SQ + (size_t)(R0 + r32) * 512 + hq * 64 + 8 * hi;
        bf16x8 qf[4];
#pragma unroll
        for (int ks = 0; ks < 4; ++ks) qf[ks] = *(const bf16x8*)(qp + 16 * ks);
        f32x16 o[2]; float lsum = 0.f;
#pragma unroll
        for (int c = 0; c < 2; ++c)
#pragma unroll
            for (int r = 0; r < 16; ++r) o[c][r] = 0.f;
        for (int j = 0; j < 5; ++j) {
            const int kt = a + j;
            if (n == 0 && kt < 4) continue;
            const LAS unsigned char* Kt = Kimg + kt * 4096; const LAS unsigned char* Vt = Vimg + kt * 4096;
            f32x16 acc;
#pragma unroll
            for (int r = 0; r < 16; ++r) acc[r] = -C2;
#pragma unroll
            for (int ks = 0; ks < 4; ++ks) { const bf16x8 kf = *(const LAS bf16x8*)(Kt + ((ks & 1) ? kbo : kbe) + 512 * (ks >> 1)); acc = MFMA32(kf, qf[ks], acc); }
#pragma unroll
            for (int r = 0; r < 16; ++r) { const int kl = (r & 3) + 8 * (r >> 2) + 4 * hi;
                const bool valid = (j == 0) ? (r32 < kl) : ((j == 4) ? (kl <= r32) : true);
                const float p = valid ? __builtin_amdgcn_exp2f(acc[r]) : 0.f; acc[r] = p; lsum += p; }
            const bf16x8 pa0 = pack_step(acc, 0), pa1 = pack_step(acc, 1);
#pragma unroll
            for (int s = 0; s < 2; ++s)
#pragma unroll
                for (int c = 0; c < 2; ++c) { const bf16x8 vf = cat8(ds_tr(Vt + s * 2048 + c * 512 + vb0), ds_tr(Vt + s * 2048 + c * 512 + vb1)); o[c] = MFMA32(vf, s ? pa1 : pa0, o[c]); }
        }
        lsum += __shfl_xor(lsum, 32);
        const float inv = frcp(lsum + __builtin_amdgcn_exp2f(sinkv * 1.4426950408889634f - C2));
#pragma unroll
        for (int c = 0; c < 2; ++c)
#pragma unroll
            for (int g = 0; g < 4; ++g) { u32x2 w; w.x = cvtpk(o[c][4 * g] * inv, o[c][4 * g + 1] * inv); w.y = cvtpk(o[c][4 * g + 2] * inv, o[c][4 * g + 3] * inv);
                *(LAS u32x2*)(stg + r32 * 144 + (32 * c + 8 * g + 4 * hi) * 2) = w; }
#pragma unroll
        for (int jj = 0; jj < 4; ++jj) { const int idx = lane + 64 * jj, row = idx >> 3, c8 = idx & 7;
            const u32x4 v = *(const LAS u32x4*)(stg + row * 144 + 16 * c8);
            *(u32x4*)(MIX + (size_t)(R0 + row) * 1024 + 512 + hq * 64 + 8 * c8) = v; }
    }
}


#define HG_BAR() asm volatile("s_waitcnt lgkmcnt(0)\n\ts_barrier" ::: "memory")
__device__ __forceinline__ void hgrn_mfma(Frame& F, int b, int h) {
    const bf16_t* QT = (const bf16_t*)(F.ws + WS_QT); const bf16_t* KT = (const bf16_t*)(F.ws + WS_KT); const bf16_t* V = (const bf16_t*)(F.ws + WS_V); const bf16_t* SG = (const bf16_t*)(F.ws + WS_SG);
    const float* ELAST = (const float*)(F.ws + WS_ELAST); bf16_t* MIX = (bf16_t*)(F.ws + WS_MIX);
    int lane = F.lane; asm volatile("" : "+v"(lane));
    const int r32 = lane & 31, hi = lane >> 5, w = F.wave, tid = w * 64 + lane;
    LAS unsigned char* img = F.lds;
    LAS unsigned char* pfrag = F.lds + 98304;
    LAS float* rowsq = (LAS float*)(F.lds + 104448);
    LAS float* elds = (LAS float*)(F.lds + 106496);
    LAS float* ngl = (LAS float*)(F.lds + 107520);
    LAS unsigned char* stg = F.lds + 108032 + (w & 3) * 5120;
    const size_t rbase = (size_t)b * SEQ; const int colh = h * 128;
    const unsigned q4 = (lane & 15) >> 2, p4 = lane & 3, blk = (lane >> 4) & 1, vc = 2 * blk + (p4 >> 1), p8 = 8u * (p4 & 1);
    const unsigned n0 = 2048u * hi + 64u * q4 + 16u * (vc ^ ((2u * hi) & 3u)) + p8, n1 = 2048u * hi + 64u * (4 + q4) + 16u * (vc ^ ((2u * hi + 1u) & 3u)) + p8;
    const unsigned k0 = 64u * (4 * hi + q4) + 16u * (vc ^ (unsigned)hi) + p8, k1 = 2048u + 64u * (4 * hi + q4) + 16u * (vc ^ (2u + hi)) + p8;
    const unsigned rb = 2048u * (r32 >> 3) + 64u * (r32 & 7), xr = (r32 >> 2) & 3;
    const unsigned rbe = rb + 16u * ((unsigned)hi ^ xr), rbo = rb + 16u * ((2u + hi) ^ xr);
    const unsigned qk00 = rb + 8u * hi + 16u * (0u ^ xr), qk01 = rb + 8u * hi + 16u * (1u ^ xr), qk10 = rb + 8u * hi + 16u * (2u ^ xr), qk11 = rb + 8u * hi + 16u * (3u ^ xr);
    __syncthreads();
#pragma unroll
    for (int i = 0; i < 6; ++i) { const int tensor = i >> 1, rem = tid + 512 * (i & 1), r = rem >> 4, ch = rem & 15;
        const bf16_t* src = (tensor == 0 ? QT : tensor == 1 ? KT : V) + (rbase + r) * 512 + colh + 8 * ch;
        *(LAS u32x4*)(img + tensor * 16384 + offa<2048>(r, ch)) = *(const u32x4*)src; }
    if (tid < 32) *(LAS f32x4*)(elds + 4 * tid) = *(const f32x4*)(ELAST + (rbase >> 6) * 512 + colh + 4 * tid);
    if (tid >= 64 && tid < 96) *(LAS f32x4*)(ngl + 4 * (tid - 64)) = *(const f32x4*)(F.hng + 4 * (tid - 64));
    __syncthreads();
    if (w < 4) {
        const int vb = w;
        f32x16 S[4];
#pragma unroll
        for (int kb = 0; kb < 4; ++kb)
#pragma unroll
            for (int r = 0; r < 16; ++r) S[kb][r] = 0.f;
        for (int c = 0; c < 32; ++c) {
            const LAS unsigned char* Qi = img + (c & 1) * 49152; const LAS unsigned char* Ki = Qi + 16384; const LAS unsigned char* Vi = Qi + 32768;
            const size_t row0 = rbase + 64 * c;
            f32x16 o[2];
#pragma unroll
            for (int tb = 0; tb < 2; ++tb)
#pragma unroll
                for (int r = 0; r < 16; ++r) o[tb][r] = 0.f;
#pragma unroll
            for (int kh = 0; kh < 2; ++kh) {
                u32x2 ql[2][2][2][2];
#pragma unroll
                for (int kl = 0; kl < 2; ++kl)
#pragma unroll
                    for (int s = 0; s < 2; ++s)
#pragma unroll
                        for (int tb = 0; tb < 2; ++tb) { const LAS unsigned char* qp = Qi + 8192 * tb + 512 * (2 * kh + kl);
                            ql[kl][s][tb][0] = *(const LAS u32x2*)(qp + (s ? qk10 : qk00)); ql[kl][s][tb][1] = *(const LAS u32x2*)(qp + (s ? qk11 : qk01)); }
                __builtin_amdgcn_sched_barrier(0);
#pragma unroll
                for (int kl = 0; kl < 2; ++kl)
#pragma unroll
                    for (int s = 0; s < 2; ++s) { const bf16x8 pa = pack_step(S[2 * kh + kl], s);
#pragma unroll
                        for (int tb = 0; tb < 2; ++tb) { const u32x4 qq = {ql[kl][s][tb][0].x, ql[kl][s][tb][0].y, ql[kl][s][tb][1].x, ql[kl][s][tb][1].y};
                            o[tb] = MFMA32(pa, __builtin_bit_cast(bf16x8, qq), o[tb]); } }
                __builtin_amdgcn_sched_barrier(0);
            }
            __builtin_amdgcn_sched_barrier(0);
#pragma unroll
            for (int ks = 0; ks < 4; ++ks) {
                const LAS unsigned char* vp = Vi + 4096 * ks + 512 * vb; const bf16x8 bfr = cat8(ds_tr(vp + n0), ds_tr(vp + n1)); bf16x8 af[4];
#pragma unroll
                for (int kb = 0; kb < 4; ++kb) { const LAS unsigned char* kp = Ki + 4096 * ks + 512 * kb; af[kb] = cat8(ds_tr(kp + n0), ds_tr(kp + n1)); }
                __builtin_amdgcn_sched_barrier(0);
#pragma unroll
                for (int kb = 0; kb < 4; ++kb) S[kb] = MFMA32(af[kb], bfr, S[kb]);
            }
            { const LAS float* ep = elds + (c & 1) * 128;
#pragma unroll
                for (int kb = 0; kb < 4; ++kb) { f32x4 e4[4];
#pragma unroll
                    for (int g = 0; g < 4; ++g) e4[g] = *(const LAS f32x4*)(ep + 32 * kb + 8 * g + 4 * hi);
#pragma unroll
                    for (int g = 0; g < 4; ++g)
#pragma unroll
                        for (int i = 0; i < 4; ++i) S[kb][4 * g + i] *= e4[g][i]; } }
            HG_BAR();
            {
                bf16x8 vf[2][2], pf[3][2];
#pragma unroll
                for (int sb = 0; sb < 2; ++sb)
#pragma unroll
                    for (int st = 0; st < 2; ++st) { const LAS unsigned char* vp = Vi + 8192 * sb + 4096 * st + 512 * vb; vf[sb][st] = cat8(ds_tr(vp + k0), ds_tr(vp + k1)); }
#pragma unroll
                for (int tl = 0; tl < 3; ++tl)
#pragma unroll
                    for (int st = 0; st < 2; ++st) pf[tl][st] = *(const LAS bf16x8*)(pfrag + (tl * 2 + st) * 1024 + lane * 16);
                __builtin_amdgcn_sched_barrier(0);
#pragma unroll
                for (int st = 0; st < 2; ++st) { o[0] = MFMA32(vf[0][st], pf[0][st], o[0]); o[1] = MFMA32(vf[0][st], pf[1][st], o[1]); o[1] = MFMA32(vf[1][st], pf[2][st], o[1]); }
            }
            f32x4 ng[4];
#pragma unroll
            for (int g = 0; g < 4; ++g) ng[g] = *(const LAS f32x4*)(ngl + 32 * vb + 8 * g + 4 * hi);
#pragma unroll
            for (int tb = 0; tb < 2; ++tb) { float ss = 0.f;
#pragma unroll
                for (int r = 0; r < 16; ++r) ss += o[tb][r] * o[tb][r];
                ss += __shfl_xor(ss, 32);
                if (hi == 0) rowsq[(c & 1) * 256 + vb * 64 + 32 * tb + r32] = ss;
#pragma unroll
                for (int g = 0; g < 4; ++g) { u32x2 v; v.x = cvtpk(o[tb][4 * g] * ng[g][0], o[tb][4 * g + 1] * ng[g][1]); v.y = cvtpk(o[tb][4 * g + 2] * ng[g][2], o[tb][4 * g + 3] * ng[g][3]);
                    *(LAS u32x2*)(stg + (c & 1) * 20480 + tb * 2560 + r32 * 80 + (8 * g + 4 * hi) * 2) = v; } }
            HG_BAR();
        }
    } else {
        const int ht = tid - 256, tile = w - 4, sb = (tile == 2) ? 1 : 0, tb = (tile == 0) ? 0 : 1;
        u32x4 sgp[2][2];
        auto hgrn_sgload = [&](int cc, int tb2) __attribute__((always_inline)) {
            const bf16_t* sgb = SG + (rbase + 64 * cc) * 512 + colh + 32 * (w - 4);
#pragma unroll
            for (int j = 0; j < 2; ++j) { const int idx = lane + 64 * j, row = idx >> 2, c8 = idx & 3, t = 32 * tb2 + row; sgp[tb2][j] = *(const u32x4*)(sgb + (unsigned)(t * 512 + 8 * c8)); }
        };
        auto hgrn_finalize = [&](int cc, int tb2) __attribute__((always_inline)) {
            const int vb = w - 4; const size_t row0 = rbase + 64 * cc;
            bf16_t* mxb = MIX + row0 * 1024 + colh + 32 * vb;
            const LAS float* rq = rowsq + (cc & 1) * 256; const LAS unsigned char* sb_ = stg + (cc & 1) * 20480 + tb2 * 2560;
#pragma unroll
            for (int j = 0; j < 2; ++j) { const int idx = lane + 64 * j, row = idx >> 2, c8 = idx & 3, t = 32 * tb2 + row;
                const u32x4 sg = sgp[tb2][j];
                const float rstd = frsq(((rq[t] + rq[64 + t]) + (rq[128 + t] + rq[192 + t])) * (1.0f / 128.0f) + EPS);
                const u32x4 a = *(const LAS u32x4*)(sb_ + row * 80 + c8 * 16);
                u32x4 ov; ov.x = cvtpk(bflo(a.x) * rstd * bflo(sg.x), bfhi(a.x) * rstd * bfhi(sg.x)); ov.y = cvtpk(bflo(a.y) * rstd * bflo(sg.y), bfhi(a.y) * rstd * bfhi(sg.y));
                ov.z = cvtpk(bflo(a.z) * rstd * bflo(sg.z), bfhi(a.z) * rstd * bfhi(sg.z)); ov.w = cvtpk(bflo(a.w) * rstd * bflo(sg.w), bfhi(a.w) * rstd * bfhi(sg.w));
                *(u32x4*)(mxb + (unsigned)(t * 1024 + 8 * c8)) = ov; }
        };
        for (int c = 0; c < 32; ++c) {
            const LAS unsigned char* Qi = img + (c & 1) * 49152; const LAS unsigned char* Ki = Qi + 16384;
            u32x4 tmp[12]; f32x4 etmp = {0.f, 0.f, 0.f, 0.f};
            const size_t nrow0 = rbase + 64 * ((c + 1 < 32) ? c + 1 : c);
            const unsigned ploff = (unsigned)(ht >> 4) * 512u + 8u * (unsigned)(ht & 15);
#pragma unroll
            for (int i = 0; i < 12; ++i) { const int tensor = i >> 2;
                const bf16_t* tb_ = (tensor == 0 ? QT : tensor == 1 ? KT : V) + nrow0 * 512 + colh + (i & 3) * 8192;
                tmp[i] = *(const u32x4*)(tb_ + ploff); }
            if (ht < 32) etmp = *(const f32x4*)(ELAST + (nrow0 >> 6) * 512 + colh + (unsigned)(4 * ht));
            if (c > 0) hgrn_finalize(c - 1, 0);
            hgrn_sgload(c, 0);
            if (w < 7) {
                f32x16 acc;
#pragma unroll
                for (int r = 0; r < 16; ++r) acc[r] = 0.f;
#pragma unroll
                for (int kh = 0; kh < 2; ++kh) {
                    bf16x8 kfr[4], qfr[4];
#pragma unroll
                    for (int kq = 0; kq < 4; ++kq) { const int ks = 4 * kh + kq; const unsigned o_ = ((ks & 1) ? rbo : rbe) + 512 * (ks >> 1); kfr[kq] = *(const LAS bf16x8*)(Ki + 8192 * sb + o_); qfr[kq] = *(const LAS bf16x8*)(Qi + 8192 * tb + o_); }
                    __builtin_amdgcn_sched_barrier(0);
#pragma unroll
                    for (int kq = 0; kq < 4; ++kq) acc = MFMA32(kfr[kq], qfr[kq], acc);
                    __builtin_amdgcn_sched_barrier(0);
                }
                if (sb == tb) {
#pragma unroll
                    for (int r = 0; r < 16; ++r) { const int sl = (r & 3) + 8 * (r >> 2) + 4 * hi; if (sl > r32) acc[r] = 0.f; } }
                *(LAS bf16x8*)(pfrag + (tile * 2 + 0) * 1024 + lane * 16) = pack_step(acc, 0);
                *(LAS bf16x8*)(pfrag + (tile * 2 + 1) * 1024 + lane * 16) = pack_step(acc, 1);
            }
            HG_BAR();
            if (c + 1 < 32) {
                LAS unsigned char* dst = img + ((c + 1) & 1) * 49152;
#pragma unroll
                for (int i = 0; i < 12; ++i) { const int tensor = i >> 2, rem = ht + 256 * (i & 3), r = rem >> 4, ch = rem & 15;
                    *(LAS u32x4*)(dst + tensor * 16384 + offa<2048>(r, ch)) = tmp[i]; }
                if (ht < 32) *(LAS f32x4*)(elds + ((c + 1) & 1) * 128 + 4 * ht) = etmp;
            }
            if (c > 0) hgrn_finalize(c - 1, 1);
            hgrn_sgload(c, 1);
            HG_BAR();
        }
        hgrn_finalize(31, 0); hgrn_finalize(31, 1);
    }
}

constexpr int NPHASE = 9;
__global__ void __launch_bounds__(512, 2) layer_fwd(Args args) {
    extern __shared__ __attribute__((aligned(16))) unsigned char lds_raw[];
    Frame F;
    F.lds = (LAS unsigned char*)lds_raw; F.tid = threadIdx.x; F.lane = F.tid & 63; F.wave = __builtin_amdgcn_readfirstlane(F.tid >> 6); F.G = gridDim.x; F.bid = blockIdx.x;
    F.x = (const float*)args.in[0]; F.mem = (const float*)args.in[1]; F.pos = (const int*)args.in[2]; F.g1 = (const float*)args.in[3]; F.w_in = (const float*)args.in[4];
    F.hlb = (const float*)args.in[5]; F.hng = (const float*)args.in[6]; F.qng = (const float*)args.in[7]; F.kng = (const float*)args.in[8]; F.sinks = (const float*)args.in[9];
    F.w_out = (const float*)args.in[10]; F.g2 = (const float*)args.in[11]; F.gm = (const float*)args.in[12]; F.wq = (const float*)args.in[13]; F.wkv = (const float*)args.in[14];
    F.xqg = (const float*)args.in[15]; F.xkg = (const float*)args.in[16]; F.wo = (const float*)args.in[17]; F.g3 = (const float*)args.in[18]; F.wup = (const float*)args.in[19]; F.wdn = (const float*)args.in[20];
    F.out = args.out; F.ws = args.ws;
    unsigned char* ws = args.ws;
    const int lo = args.ph_lo, hi = args.ph_hi;
#ifndef PH_MASK
#define PH_MASK 0x1ff
#endif
#define IN(k) (((PH_MASK >> (k)) & 1) && lo <= (k) && (k) < hi)
#ifndef GSYNC_SEAM
#define GSYNC_SEAM -1
#endif
    if (F.tid < 64) ((LAS unsigned*)(F.lds + LDSCTL_OFF))[F.tid] = 0u;
    __syncthreads();
#if MK_N_LAUNCHES == 1
    static_assert(GSYNC_SEAM == -1, "the executed grid.sync() is the one below");
    if (F.bid == 0) { unsigned* bz = (unsigned*)(ws + WS_CTL) + 4096;
#pragma unroll
        for (int i = 0; i < 8; ++i) bz[F.tid + 512 * i] = 0u; }
    cg::this_grid().sync();
    XcdBarrier xbar = xcd_barrier_post((unsigned*)(ws + WS_CTL) + 4096, (volatile LAS unsigned*)(F.lds + LDSCTL_OFF) + 8);
#else
    XcdBarrier xbar = xcd_barrier_post((unsigned*)(ws + WS_CTL) + 4096, (volatile LAS unsigned*)(F.lds + LDSCTL_OFF) + 8);
#endif
    int vb_ = F.bid; bool xl_ok = false;
#define LSEAM(k) do { if (IN(k) && IN((k) + 1)) { if (xl_ok) xcc_local_barrier(xbar, (unsigned)(F.G >> 3)); else xcd_barrier(xbar); } } while (0)
#define SEAM(k) do { if (IN(k) && IN((k) + 1)) { if ((k) == GSYNC_SEAM) cg::this_grid().sync(); else xcd_barrier(xbar); } } while (0)
    float* ss2 = (float*)(ws + WS_SS2); float* ss3 = (float*)(ws + WS_SS3);

#ifndef DUP_MASK
#define DUP_MASK 0
#endif
#define NREP(k) (1 + ((DUP_MASK >> (k)) & 1))
    if (IN(0)) { for (int rep = 0; rep < NREP(0); ++rep) p0_prologue(F); }
    SEAM(0);
    const bool hsplit = F.G >= 128;
    pg8::EpiP1 EP1{(bf16_t*)(ws + WS_QT), (bf16_t*)(ws + WS_KT), (bf16_t*)(ws + WS_V), (bf16_t*)(ws + WS_SG), (bf16_t*)(ws + WS_SQ), (bf16_t*)(ws + WS_SK), (bf16_t*)(ws + WS_SV), (bf16_t*)(ws + WS_KVM),
                   (float*)(ws + WS_ELAST), (const float*)(ws + WS_LB), F.qng, F.kng, (const float*)(ws + WS_ROPE)};
    if (IN(1)) {
        pg8::Sched S; S.A0 = (const char*)(ws + WS_HN1); S.B0 = (const char*)(ws + WS_WIN); S.A1 = (const char*)(ws + WS_MN); S.B1 = (const char*)(ws + WS_WKV);
        S.nM0 = M / 256; S.nN0 = hsplit ? 8 : INW / 256; S.n0 = S.nM0 * S.nN0; S.n1 = hsplit ? 0 : (MM / 256) * 4; S.G = F.G; S.c = F.bid; S.tstep = (size_t)256 * D * 2; S.nrep = 1;
        pg8::gemm_phase<pg8::EpiP1, true, true>(F.lds, D, S, EP1);
    }
    SEAM(1);
    if (IN(2)) {
        if (hsplit) {
            if (F.bid < 64) { xcd_barrier_arrive(xbar); hgrn_mfma(F, F.bid >> 2, F.bid & 3); xcd_barrier_wait(xbar); }
            else {
                pg8::Sched S; S.A0 = (const char*)(ws + WS_HN1); S.B0 = (const char*)(ws + WS_WIN); S.A1 = (const char*)(ws + WS_MN); S.B1 = (const char*)(ws + WS_WKV);
                S.nM0 = M / 256; S.nN0 = INW / 256 - 8; S.pnoff = 8; S.n0 = S.nM0 * S.nN0; S.n1 = (MM / 256) * 4; S.G = F.G - 64; S.c = F.bid - 64; S.tstep = (size_t)256 * D * 2; S.nrep = 1;
                pg8::gemm_phase<pg8::EpiP1, true, true>(F.lds, D, S, EP1);
                __syncthreads();
                const int nu = S.n0 + S.n1, rem = nu % S.G, nlt = (rem == 0) ? S.G : S.G - rem, lt0 = (rem == 0) ? 0 : rem;
                if (S.c >= lt0) transpose_items(F, ITEMS_EARLY, ITEMS_ALL, (S.c - lt0) * 8 + F.wave, nlt * 8);
                xcd_barrier(xbar);
            }
            for (int u = F.bid; u < 512; u += F.G) swa_unit(F, u);
            __syncthreads();
            if (F.bid >= 64) kn_items(F, (F.bid - 64) * 8 + F.wave, (F.G - 64) * 8);
        } else {
            for (int u = F.bid; u < 64; u += F.G) hgrn_mfma(F, (u & 63) >> 2, u & 3);
            __syncthreads();
            for (int u = F.bid; u < 512; u += F.G) swa_unit(F, u & 511);
        }
    }
    SEAM(2);
    {
        volatile LAS unsigned* st_ = (volatile LAS unsigned*)(F.lds + LDSCTL_OFF) + 8;
        if (F.tid == 0) { unsigned ok = ((F.G & 7) == 0) ? 1u : 0u; const unsigned per = (unsigned)(F.G >> 3);
            for (unsigned j = 0; j < 16; ++j) { const unsigned c_ = xb_ld(&xbar.bar[XB_XCNT(j)]); if (c_ != (j < 8 ? per : 0u)) ok = 0u; }
            st_[3] = ok; }
        __syncthreads();
        xl_ok = st_[3] != 0u;
        if (xl_ok) vb_ = (int)xbar.x + 8 * (int)st_[2];
    }
    if (IN(3)) {
        pg8::Sched S; S.A0 = (const char*)(ws + WS_MIX); S.B0 = (const char*)(ws + WS_WOUT); S.A1 = S.A0; S.B1 = S.B0;
        S.nM0 = M / 256; S.nN0 = 4; S.n0 = S.nM0 * 4; S.n1 = 0; S.G = F.G; S.c = vb_; S.tstep = (size_t)256 * D * 2; S.nrep = NREP(3);
        pg8::EpiRes<false> E{F.x, nullptr, (bf16_t*)(ws + WS_HB), ss2};
        pg8::gemm_phase<pg8::EpiRes<false>, true, true>(F.lds, D, S, E);
    }
    LSEAM(3);
    if (IN(4)) {
        if (F.G < 128) for (int it = F.bid * 8 + F.wave; it < MM * 4; it += F.G * 8) kn_item(F, it);
        pg8::Sched S; S.A0 = (const char*)(ws + WS_HB); S.B0 = (const char*)(ws + WS_WQ); S.A1 = S.A0; S.B1 = S.B0;
        S.nM0 = M / 256; S.nN0 = 2; S.n0 = S.nM0 * 2; S.n1 = 0; S.G = F.G; S.c = vb_; S.tstep = (size_t)256 * D * 2; S.nrep = NREP(4);
        pg8::EpiScale<0> E{(bf16_t*)(ws + WS_QX), 512, ss2};
        pg8::gemm_phase<pg8::EpiScale<0>, true, true>(F.lds, D, S, E);
    }
    LSEAM(4);
    if (IN(5)) {
        for (int pr = xl_ok ? ((vb_ & 7) * (F.G >> 3) + (vb_ >> 3)) : F.bid; pr < 256; pr += F.G) xattn_pair(F, pr);
    }
    LSEAM(5);
    if (IN(6)) {
        pg8::Sched S; S.A0 = (const char*)(ws + WS_XO); S.B0 = (const char*)(ws + WS_WO); S.A1 = S.A0; S.B1 = S.B0;
        S.nM0 = M / 256; S.nN0 = 4; S.n0 = S.nM0 * 4; S.n1 = 0; S.G = F.G; S.c = vb_; S.tstep = (size_t)256 * 512 * 2; S.nrep = NREP(6);
        pg8::EpiRes<true> E{nullptr, (const bf16_t*)(ws + WS_HB), (bf16_t*)(ws + WS_HB), ss3};
        pg8::gemm_phase<pg8::EpiRes<true>, true, true>(F.lds, 512, S, E);
    }
    LSEAM(6);
    if (IN(7)) {
        pg8::Sched S; S.A0 = (const char*)(ws + WS_HB); S.B0 = (const char*)(ws + WS_WUP); S.A1 = S.A0; S.B1 = S.B0;
        S.nM0 = M / 256; S.nN0 = 16; S.n0 = S.nM0 * 16; S.n1 = 0; S.G = F.G; S.c = vb_; S.tstep = (size_t)256 * D * 2; S.nrep = NREP(7);
        pg8::EpiScale<1> E{(bf16_t*)(ws + WS_ACT), FF, ss3};
        pg8::gemm_phase<pg8::EpiScale<1>, true, true>(F.lds, D, S, E);
    }
    LSEAM(7);
    if (IN(8)) {
        pg8::Sched S; S.A0 = (const char*)(ws + WS_ACT); S.B0 = (const char*)(ws + WS_WDN); S.A1 = S.A0; S.B1 = S.B0;
        S.nM0 = M / 256; S.nN0 = 4; S.n0 = S.nM0 * 4; S.n1 = 0; S.G = F.G; S.c = vb_; S.tstep = (size_t)256 * FF * 2; S.nrep = NREP(8);
        pg8::EpiAdd E{(const bf16_t*)(ws + WS_HB), F.out, ss3};
        pg8::gemm_phase<pg8::EpiAdd, true, true>(F.lds, FF, S, E);
    }
#undef IN
#undef SEAM
}

extern "C" void kernel_launch(void* const* d_in, const int* in_sizes, int n_in, void* d_out, int out_size, void* d_ws, size_t ws_size, hipStream_t stream) {
    static int grid = 0;
    if (grid == 0) {
        if (n_in != 21 || in_sizes[0] != M * D || out_size != M * D || ws_size < WS_END) { fprintf(stderr, "kernel_launch: unexpected shapes (n_in %d, ws %zu)\n", n_in, ws_size); grid = -1; return; }
        int dev = 0, cus = 0, per_cu = 0;
        (void)hipGetDevice(&dev); (void)hipDeviceGetAttribute(&cus, hipDeviceAttributeMultiprocessorCount, dev);
        (void)hipFuncSetAttribute((const void*)layer_fwd, hipFuncAttributeMaxDynamicSharedMemorySize, LDS_BYTES);
        (void)hipOccupancyMaxActiveBlocksPerMultiprocessor(&per_cu, (const void*)layer_fwd, 512, LDS_BYTES);
        if (per_cu < 1) per_cu = 1;
        if (per_cu > 1) per_cu = 1;
        grid = cus * per_cu; (void)hipGetLastError();
    }
    if (grid < 0) return;
#if MK_N_LAUNCHES != 1
    (void)hipMemsetAsync((char*)d_ws + WS_CTL, 0, CTL_ZERO_BYTES, stream);
#endif
    Args a{};
    for (int i = 0; i < 21; ++i) a.in[i] = d_in[i];
    a.out = (float*)d_out; a.ws = (unsigned char*)d_ws;
#if MK_N_LAUNCHES == 1
    a.ph_lo = 0; a.ph_hi = NPHASE;
    void* kargs[] = {&a};
    hipError_t e = hipLaunchCooperativeKernel((const void*)layer_fwd, dim3(grid), dim3(512), kargs, LDS_BYTES, stream);
    if (e != hipSuccess) fprintf(stderr, "cooperative launch failed: %s (grid %d)\n", hipGetErrorString(e), grid);
#else
    for (int p = 0; p < NPHASE; ++p) { a.ph_lo = p; a.ph_hi = p + 1; hipLaunchKernelGGL(layer_fwd, dim3(grid), dim3(512), LDS_BYTES, stream, a); }
#endif
}
```
